# Optimizing an MI355X kernel written in HIP

```python
import jax, jax.numpy as jnp
from jax import lax
import numpy as np

D_MODEL = 1024
BATCH = 4
SEQ = 4096
DEPTH = 2

GRID_W = 64
CTX_LEN = 256
EPS = 1e-6
N_BRANCH = 4
BRANCH_W = D_MODEL // 4
D_FF = 4 * D_MODEL

POOL_GROUPS = 4
POOL_GC = BRANCH_W // POOL_GROUPS
POOL_WINDOWS = (2, 4, 8, 16)
POOL_W = POOL_GROUPS * POOL_GC

MLA_HEADS = 4
MLA_Q_RANK = D_MODEL // 4
MLA_KV_RANK = D_MODEL // 8
MLA_NOPE = 64
MLA_ROPE = 32
MLA_V = 64
MLA_QK = MLA_NOPE + MLA_ROPE
ROPE_BASE = 10000.0
Q_BLOCK = 128

NA_HEADS = 4
NA_HD = 64
NA_WIN_R = 8
NA_WIN_C = 16

HG_HEADS = 4
HG_DK = 64
HG_DV = 64
HG_CHUNK = 64
LB_EPS = 1e-6

KV_SIZES = (MLA_KV_RANK + MLA_ROPE, NA_HEADS * NA_HD, NA_HEADS * NA_HD,
            HG_HEADS * HG_DK, HG_HEADS * HG_DK, HG_HEADS * HG_DV)
Q_SIZES = (POOL_W, MLA_Q_RANK, NA_HEADS * NA_HD, HG_HEADS * HG_DK, HG_HEADS * HG_DV,
           N_BRANCH * D_MODEL)
KV_COLS = sum(KV_SIZES)
D_IN = KV_COLS + sum(Q_SIZES)

kernel_name = 'hybrid_dit_pool_mla_natten_hgrn2'


def rmsnorm(x, g):
    xf = x.astype(jnp.float32)
    y = xf * lax.rsqrt(jnp.mean(xf * xf, axis=-1, keepdims=True) + EPS)
    return (y * g.astype(jnp.float32)).astype(x.dtype)


def modulate(x, g, shift, scale):
    return rmsnorm(x, g) * (1 + scale) + shift


def split_cols(u, sizes):
    return jnp.split(u, [int(s) for s in np.cumsum(sizes)[:-1]], axis=-1)


def split_heads(u, n_heads, g=None):
    B, L, _ = u.shape
    h = u.reshape(B, L, n_heads, -1)
    if g is not None:
        h = rmsnorm(h, g)
    return h.transpose(0, 2, 1, 3)


def merge_heads(o):
    B, H, L, d = o.shape
    return o.transpose(0, 2, 1, 3).reshape(B, L, H * d)


def axial_rope_tables(n_tok):
    t = jnp.arange(n_tok)
    pos = jnp.stack([t // GRID_W, t % GRID_W], axis=-1).astype(jnp.float32)
    nf = MLA_ROPE // 4
    inv = ROPE_BASE ** (-jnp.arange(nf, dtype=jnp.float32) / nf)
    ang = pos[:, :, None] * inv
    return jnp.cos(ang), jnp.sin(ang)


def apply_axial_rope(x, cos, sin):
    sh = x.shape
    xs = x.reshape(sh[:-1] + (2, 2, MLA_ROPE // 4)).astype(jnp.float32)
    x1, x2 = xs[..., 0, :], xs[..., 1, :]
    out = jnp.stack([x1 * cos - x2 * sin, x2 * cos + x1 * sin], axis=-2)
    return out.reshape(sh).astype(x.dtype)


def rotate_tail(x, rope):
    return jnp.concatenate([x[..., :MLA_NOPE], apply_axial_rope(x[..., MLA_NOPE:], rope[0], rope[1])], axis=-1)


def mla_queries(qa, q_norm, w_qb, gq, rope):
    B, L, _ = qa.shape
    q = (rmsnorm(qa, q_norm) @ w_qb).reshape(B, L, MLA_HEADS, MLA_QK)
    q = rmsnorm(q, gq).transpose(0, 2, 1, 3)
    if rope is not None:
        q = rotate_tail(q, rope)
    return q


def mla_keys_values(kva, kv_norm, w_kvb, gk, rope):
    B, L, _ = kva.shape
    ckv, k_rope = kva[..., :MLA_KV_RANK], kva[..., MLA_KV_RANK:]
    kv = (rmsnorm(ckv, kv_norm) @ w_kvb).reshape(B, L, MLA_HEADS, MLA_NOPE + MLA_V)
    k = jnp.concatenate([kv[..., :MLA_NOPE],
                         jnp.broadcast_to(k_rope[:, :, None, :], (B, L, MLA_HEADS, MLA_ROPE))], axis=-1)
    k = rmsnorm(k, gk).transpose(0, 2, 1, 3)
    v = kv[..., MLA_NOPE:].transpose(0, 2, 1, 3)
    if rope is not None:
        k = rotate_tail(k, rope)
    return k, v


def dense_attention(q, k, v, scale):
    B, H, L, dq = q.shape
    nb = L // Q_BLOCK
    qb = q.reshape(B, H, nb, Q_BLOCK, dq).transpose(2, 0, 1, 3, 4)

    def one_block(qi):
        s = jnp.einsum('bhqd,bhkd->bhqk', qi, k).astype(jnp.float32) * scale
        pr = jax.nn.softmax(s, axis=-1).astype(v.dtype)
        return jnp.einsum('bhqk,bhkd->bhqd', pr, v)

    o = lax.map(one_block, qb)
    return o.transpose(1, 2, 0, 3, 4).reshape(B, H, L, v.shape[-1])


def na_tables(rows, rpb):
    wr = min(NA_WIN_R, rows)
    r = jnp.arange(rows)
    col = jnp.arange(GRID_W)
    rs = jnp.clip(r - NA_WIN_R // 2, 0, rows - wr)
    cs = jnp.clip(col - NA_WIN_C // 2, 0, GRID_W - NA_WIN_C)
    key_r = rs[:, None] + jnp.arange(wr)
    key_c = cs[:, None] + jnp.arange(NA_WIN_C)
    idx = (key_r[:, None, :, None] * GRID_W + key_c[None, :, None, :]).reshape(rows, GRID_W, wr * NA_WIN_C)
    dr = key_r - r[:, None] + NA_WIN_R - 1
    dc = key_c - col[:, None] + NA_WIN_C - 1
    bias = rpb[:, dr[:, None, :, None], dc[None, :, None, :]].reshape(NA_HEADS, rows, GRID_W, wr * NA_WIN_C)
    return idx, bias.astype(jnp.float32)


def na_attention(q, k, v, k_ctx, v_ctx, rpb):
    B, H, L, d = q.shape
    rows = L // GRID_W
    idx, bias = na_tables(rows, rpb)
    n_loc = idx.shape[-1]
    scale = NA_HD ** -0.5
    qr = q.reshape(B, H, rows, GRID_W, d).transpose(2, 0, 1, 3, 4)

    def one_row(args):
        qi, ii, bi = args
        k_loc = k[:, :, ii]
        v_loc = v[:, :, ii]
        s_loc = jnp.einsum('bhqd,bhqnd->bhqn', qi, k_loc).astype(jnp.float32) * scale + bi
        s_ctx = jnp.einsum('bhqd,bhkd->bhqk', qi, k_ctx).astype(jnp.float32) * scale
        pr = jax.nn.softmax(jnp.concatenate([s_loc, s_ctx], axis=-1), axis=-1).astype(v.dtype)
        return (jnp.einsum('bhqn,bhqnd->bhqd', pr[..., :n_loc], v_loc)
                + jnp.einsum('bhqk,bhkd->bhqd', pr[..., n_loc:], v_ctx))

    o = lax.map(one_row, (qr, idx, bias.transpose(1, 0, 2, 3)))
    return o.transpose(1, 2, 0, 3, 4).reshape(B, H, L, d)


def pool_mix(u, w_grp, scale):
    B, L, _ = u.shape
    uf = u.astype(jnp.float32)
    csum = jnp.concatenate([jnp.zeros((B, 1, POOL_W), jnp.float32), jnp.cumsum(uf, axis=1)], axis=1)
    t = jnp.arange(L)
    groups = []
    for gi, w in enumerate(POOL_WINDOWS):
        lo = jnp.clip(t - w // 2, 0, L)
        hi = jnp.clip(t - w // 2 + w, 0, L)
        cg = csum[..., gi * POOL_GC:(gi + 1) * POOL_GC]
        cnt = (hi - lo).astype(jnp.float32)[None, :, None]
        groups.append((cg[:, hi] - cg[:, lo]) / cnt - uf[..., gi * POOL_GC:(gi + 1) * POOL_GC])
    p = jnp.stack(groups, axis=2)
    y = jnp.einsum('blgc,gcd->blgd', p, w_grp.astype(jnp.float32)).reshape(B, L, POOL_W)
    return (y * scale.astype(jnp.float32)).astype(u.dtype)


def hgrn_gates(z, lb):
    logf = jnp.logaddexp(jax.nn.log_sigmoid(z), jnp.log(lb) + jax.nn.log_sigmoid(-z))
    k = (1 - lb) * jax.nn.sigmoid(-z)
    return logf, k


def hgrn_scan(q, k, logf, i, s0):
    B, H, L, _ = k.shape
    nc = L // HG_CHUNK

    def chunks(a):
        return a.reshape(B, H, nc, HG_CHUNK, a.shape[-1]).transpose(2, 0, 1, 3, 4)

    lower_tri = jnp.tril(jnp.ones((HG_CHUNK, HG_CHUNK), dtype=bool))[:, :, None]

    def advance(S, b, kc, ic):
        bl = b[:, :, -1]
        return jnp.exp(bl)[..., None] * S + jnp.einsum('bhsd,bhsv->bhdv', kc * jnp.exp(bl[:, :, None] - b), ic)

    if q is None:
        def state_step(S, xs):
            kc, fc, ic = xs
            return advance(S, jnp.cumsum(fc, axis=2), kc, ic), None
        S_fin, _ = lax.scan(state_step, s0, (chunks(k), chunks(logf), chunks(i)))
        return None, S_fin

    def step(S, xs):
        qc, kc, fc, ic = xs
        b = jnp.cumsum(fc, axis=2)
        diff = b[:, :, :, None, :] - b[:, :, None, :, :]
        dec = jnp.where(lower_tri, jnp.exp(jnp.minimum(diff, 0.0)), 0.0)
        a = jnp.einsum('bhtd,bhsd,bhtsd->bhts', qc, kc, dec)
        o = jnp.einsum('bhts,bhsv->bhtv', a, ic) + jnp.einsum('bhtd,bhdv->bhtv', qc * jnp.exp(b), S)
        return advance(S, b, kc, ic), o

    S_fin, o = lax.scan(step, s0, (chunks(q), chunks(k), chunks(logf), chunks(i)))
    return o.transpose(1, 2, 0, 3, 4).reshape(B, H, L, -1), S_fin


def hgrn_inputs(kv, lbF, lbB):
    zF = split_heads(kv[3], HG_HEADS).astype(jnp.float32)
    zB = split_heads(kv[4], HG_HEADS).astype(jnp.float32)
    fF, kF = hgrn_gates(zF, lbF)
    fB, kB = hgrn_gates(zB, lbB)
    i = split_heads(kv[5], HG_HEADS).astype(jnp.float32)
    return fF, kF, fB, kB, i


def hgrn_readout(o, g_cols, g_norm):
    y = merge_heads(rmsnorm(o, g_norm))
    return (y * jax.nn.sigmoid(g_cols.astype(jnp.float32))).astype(g_cols.dtype)


def flip(a):
    return jnp.flip(a, axis=2)


def merge_branches(branches, gate_cols, w_br, w_o):
    B, L, _ = gate_cols.shape
    gates = jax.nn.sigmoid(gate_cols.reshape(B, L, N_BRANCH, D_MODEL))
    y = jnp.stack(branches, axis=2)
    proj = jnp.einsum('blnw,nwd->blnd', y, w_br)
    return jnp.einsum('bld,de->ble', jnp.sum(gates * proj, axis=2), w_o)


def sqrelu_mlp(h, w1, w2):
    return jnp.square(jax.nn.relu(h @ w1)) @ w2


def setup_inputs(seed: int = 0) -> dict:
    key = jax.random.key(seed)
    ks = jax.random.split(key, 32)
    D = D_MODEL

    def nrm(k, shape, s):
        return jax.random.normal(k, shape, jnp.float32) * s

    def gain(k, shape):
        return 1.0 + 0.05 * jax.random.normal(k, shape, jnp.float32)

    return {
        'x': nrm(ks[0], (BATCH, SEQ, D), 1.0),
        'c': nrm(ks[1], (BATCH, D), 1.0),
        'ctx': nrm(ks[2], (BATCH, CTX_LEN, D), 1.0),
        'c_ctx': nrm(ks[3], (D,), 1.0),
        'ada_w': nrm(ks[4], (DEPTH, D, 6 * D), D ** -0.5),
        'ada_b': nrm(ks[5], (DEPTH, 6 * D), 0.02),
        'norm1': gain(ks[6], (DEPTH, D)),
        'norm2': gain(ks[7], (DEPTH, D)),
        'w_in': nrm(ks[8], (DEPTH, D, D_IN), D ** -0.5),
        'pool_w': nrm(ks[9], (DEPTH, POOL_GROUPS, POOL_GC, POOL_GC), POOL_GC ** -0.5),
        'pool_scale': gain(ks[10], (DEPTH, POOL_W)),
        'mla_q_norm': gain(ks[11], (DEPTH, MLA_Q_RANK)),
        'mla_wq_b': nrm(ks[12], (DEPTH, MLA_Q_RANK, MLA_HEADS * MLA_QK), MLA_Q_RANK ** -0.5),
        'mla_kv_norm': gain(ks[13], (DEPTH, MLA_KV_RANK)),
        'mla_wkv_b': nrm(ks[14], (DEPTH, MLA_KV_RANK, MLA_HEADS * (MLA_NOPE + MLA_V)), MLA_KV_RANK ** -0.5),
        'mla_gq': gain(ks[15], (DEPTH, MLA_QK)),
        'mla_gk': gain(ks[16], (DEPTH, MLA_QK)),
        'na_gq': gain(ks[17], (DEPTH, NA_HD)),
        'na_gk': gain(ks[18], (DEPTH, NA_HD)),
        'na_rpb': nrm(ks[19], (DEPTH, NA_HEADS, 2 * NA_WIN_R - 1, 2 * NA_WIN_C - 1), 0.1),
        'hg_lb': nrm(ks[20], (DEPTH + 1, 2, HG_HEADS * HG_DK), 0.5),
        'hg_norm': gain(ks[21], (DEPTH, HG_DV)),
        'w_branch': nrm(ks[22], (DEPTH, N_BRANCH, BRANCH_W, D), BRANCH_W ** -0.5),
        'w_out': nrm(ks[23], (DEPTH, D, D), D ** -0.5),
        'w_ff1': nrm(ks[24], (DEPTH, D, D_FF), D ** -0.5),
        'w_ff2': nrm(ks[25], (DEPTH, D_FF, D), D_FF ** -0.5),
    }


def reference(x, c, ctx, c_ctx, ada_w, ada_b, norm1, norm2, w_in, pool_w, pool_scale,
              mla_q_norm, mla_wq_b, mla_kv_norm, mla_wkv_b, mla_gq, mla_gk,
              na_gq, na_gk, na_rpb, hg_lb, hg_norm, w_branch, w_out, w_ff1, w_ff2):
    B, L, D = x.shape
    rope = axial_rope_tables(L)
    lb_p = jax.nn.softmax(hg_lb.astype(jnp.float32), axis=0)
    lb_all = jnp.clip(jnp.cumsum(lb_p, axis=0)[:DEPTH], LB_EPS, 1.0 - LB_EPS)
    s_lat = jax.nn.silu(c)
    s_ctx = jax.nn.silu(c_ctx)
    mla_scale = MLA_QK ** -0.5
    hg_qscale = HG_DK ** -0.5
    xl, xc = x, ctx
    for l in range(DEPTH):
        ctx_out = l < DEPTH - 1
        mod_l = (s_lat @ ada_w[l] + ada_b[l])[:, None, :]
        sh1, sc1, g1, sh2, sc2, g2 = jnp.split(mod_l, 6, axis=-1)
        n_mod = 6 if ctx_out else 2
        mods_c = jnp.split(s_ctx @ ada_w[l][:, :n_mod * D] + ada_b[l][:n_mod * D], n_mod)
        lbF = lb_all[l, 0].reshape(HG_HEADS, 1, HG_DK)
        lbB = lb_all[l, 1].reshape(HG_HEADS, 1, HG_DK)

        hl = modulate(xl, norm1[l], sh1, sc1)
        hc = modulate(xc, norm1[l], mods_c[0], mods_c[1])
        ul = hl @ w_in[l]
        kv_l = split_cols(ul[..., :KV_COLS], KV_SIZES)
        q_l = split_cols(ul[..., KV_COLS:], Q_SIZES)
        uc = hc @ (w_in[l] if ctx_out else w_in[l][:, :KV_COLS])
        kv_c = split_cols(uc[..., :KV_COLS], KV_SIZES)

        k_mla_c, v_mla_c = mla_keys_values(kv_c[0], mla_kv_norm[l], mla_wkv_b[l], mla_gk[l], None)
        k_na_c = split_heads(kv_c[1], NA_HEADS, na_gk[l])
        v_na_c = split_heads(kv_c[2], NA_HEADS)
        fFc, kFc, fBc, kBc, ic = hgrn_inputs(kv_c, lbF, lbB)
        zeros = jnp.zeros((B, HG_HEADS, HG_DK, HG_DV), jnp.float32)
        if ctx_out:
            q_c = split_cols(uc[..., KV_COLS:], Q_SIZES)
            qc_hg = split_heads(q_c[3], HG_HEADS).astype(jnp.float32) * hg_qscale
            oFc, SFc = hgrn_scan(qc_hg, kFc, fFc, ic, zeros)
            oBc, SBc = hgrn_scan(flip(qc_hg), flip(kBc), flip(fBc), flip(ic), zeros)
        else:
            _, SFc = hgrn_scan(None, kFc, fFc, ic, zeros)
            _, SBc = hgrn_scan(None, flip(kBc), flip(fBc), flip(ic), zeros)

        a_l = pool_mix(q_l[0], pool_w[l], pool_scale[l])
        q_mla = mla_queries(q_l[1], mla_q_norm[l], mla_wq_b[l], mla_gq[l], rope)
        k_mla, v_mla = mla_keys_values(kv_l[0], mla_kv_norm[l], mla_wkv_b[l], mla_gk[l], rope)
        b_l = merge_heads(dense_attention(q_mla, jnp.concatenate([k_mla, k_mla_c], axis=2),
                                          jnp.concatenate([v_mla, v_mla_c], axis=2), mla_scale))
        q_na = split_heads(q_l[2], NA_HEADS, na_gq[l])
        k_na = split_heads(kv_l[1], NA_HEADS, na_gk[l])
        v_na = split_heads(kv_l[2], NA_HEADS)
        c_l = merge_heads(na_attention(q_na, k_na, v_na, k_na_c, v_na_c, na_rpb[l]))
        fFl, kFl, fBl, kBl, il = hgrn_inputs(kv_l, lbF, lbB)
        ql_hg = split_heads(q_l[3], HG_HEADS).astype(jnp.float32) * hg_qscale
        oFl, _ = hgrn_scan(ql_hg, kFl, fFl, il, SFc)
        oBl, _ = hgrn_scan(flip(ql_hg), flip(kBl), flip(fBl), flip(il), SBc)
        d_l = hgrn_readout(oFl + flip(oBl), q_l[4], hg_norm[l])
        y_l = merge_branches([a_l, b_l, c_l, d_l], q_l[5], w_branch[l], w_out[l])

        if ctx_out:
            a_c = pool_mix(q_c[0], pool_w[l], pool_scale[l])
            q_mla_c = mla_queries(q_c[1], mla_q_norm[l], mla_wq_b[l], mla_gq[l], None)
            b_c = merge_heads(dense_attention(q_mla_c, k_mla_c, v_mla_c, mla_scale))
            q_na_c = split_heads(q_c[2], NA_HEADS, na_gq[l])
            c_c = merge_heads(dense_attention(q_na_c, k_na_c, v_na_c, NA_HD ** -0.5))
            d_c = hgrn_readout(oFc + flip(oBc), q_c[4], hg_norm[l])
            y_c = merge_branches([a_c, b_c, c_c, d_c], q_c[5], w_branch[l], w_out[l])
            xc = xc + mods_c[2] * y_c
            xc = xc + mods_c[5] * sqrelu_mlp(modulate(xc, norm2[l], mods_c[3], mods_c[4]), w_ff1[l], w_ff2[l])

        xl = xl + g1 * y_l
        xl = xl + g2 * sqrelu_mlp(modulate(xl, norm2[l], sh2, sc2), w_ff1[l], w_ff2[l])
    return xl
```

```cpp
#include <hip/hip_runtime.h>
#include <hip/hip_cooperative_groups.h>
#include <cstdio>
namespace cg = cooperative_groups;

typedef unsigned short u16;
typedef __attribute__((ext_vector_type(8))) short bf16x8;
typedef __attribute__((ext_vector_type(4))) float f32x4;
#define DI __device__ __forceinline__
#define MFMA(a, b, c) __builtin_amdgcn_mfma_f32_16x16x32_bf16((a), (b), (c), 0, 0, 0)

constexpr int D = 1024, LAT = 4096, CL = 256, TB = LAT + CL;
constexpr int RH = 2 * TB;
constexpr int NU = 6912;
constexpr int DIN = 6816, DFF = 4096;
constexpr float EPS = 1e-6f;
constexpr int U_KVA = 0, U_KNA = 160, U_VNA = 416, U_ZF = 672, U_I = 1184, U_POOL = 1440, U_QA = 1696,
              U_QNA = 1952, U_QHG = 2208, U_GHG = 2464, U_GATE = 2720;
enum { IX = 0, IC, ICTX, ICCTX, IADAW, IADAB, INORM1, INORM2, IWIN, IPOOLW, IPOOLS, IQNORM, IWQB, IKVNORM, IWKVB,
       IGQ, IGK, INAGQ, INAGK, IRPB, IHGLB, IHGNORM, IWBR, IWOUT, IWFF1, IWFF2, NIN };

constexpr size_t al256(size_t x) { return (x + 255) & ~(size_t)255; }
constexpr size_t WS_MOD  = 0;
constexpr size_t WS_XC   = al256(WS_MOD + (size_t)2 * 5 * 6144 * 4);
constexpr size_t WS_WIN  = al256(WS_XC + (size_t)4 * CL * D * 4);
constexpr size_t WS_WFF1 = al256(WS_WIN + (size_t)NU * D * 2);
constexpr size_t WS_WFF2 = al256(WS_WFF1 + (size_t)DFF * D * 2);
constexpr size_t WS_WO   = al256(WS_WFF2 + (size_t)DFF * D * 2);
constexpr size_t WS_WBR  = al256(WS_WO + (size_t)D * D * 2);
constexpr size_t WS_WQB  = al256(WS_WBR + (size_t)D * D * 2);
constexpr size_t WS_WKVB = al256(WS_WQB + (size_t)384 * 256 * 2);
constexpr size_t WS_WPOOL= al256(WS_WKVB + (size_t)512 * 128 * 2);
constexpr size_t WS_H    = al256(WS_WPOOL + (size_t)4 * 64 * 64 * 2);
constexpr size_t WS_U    = al256(WS_H + (size_t)RH * D * 2);
constexpr size_t WS_QM   = al256(WS_U + (size_t)RH * NU * 2);
constexpr size_t WS_KM   = al256(WS_QM + (size_t)RH * 512 * 2);
constexpr size_t WS_VTM  = al256(WS_KM + (size_t)RH * 512 * 2);
constexpr size_t WS_QN   = al256(WS_VTM + (size_t)2 * 4 * 64 * TB * 2);
constexpr size_t WS_KN   = al256(WS_QN + (size_t)RH * 256 * 2);
constexpr size_t WS_VTN  = al256(WS_KN + (size_t)RH * 256 * 2);
constexpr size_t WS_Y    = al256(WS_VTN + (size_t)2 * 4 * 64 * TB * 2);
constexpr size_t WS_S    = al256(WS_Y + (size_t)RH * D * 2);
constexpr size_t WS_DEC  = al256(WS_S + (size_t)16 * 68 * 4096 * 4);
constexpr size_t WS_BAR  = al256(WS_DEC + (size_t)16 * 68 * 64 * 4);
constexpr size_t WS_END  = al256(WS_BAR + (size_t)3456 * 4);

struct Params {
  const float* in[NIN];
  float* out;
  unsigned char* ws;
};

DI int otid() { int t = threadIdx.x; asm volatile("" : "+v"(t)); return t; }
typedef __bf16 bf16v2 __attribute__((ext_vector_type(2)));
DI u16 f2bf(float x) { return __builtin_bit_cast(u16, (__bf16)x); }
DI float bf2f(u16 h) { return __uint_as_float(((unsigned)h) << 16); }
DI unsigned pack2(float a, float b) { bf16v2 v; v[0] = (__bf16)a; v[1] = (__bf16)b; return __builtin_bit_cast(unsigned, v); }
DI void unpack8(uint4 r, float* f) {
  f[0] = __uint_as_float(r.x << 16); f[1] = __uint_as_float(r.x & 0xffff0000u);
  f[2] = __uint_as_float(r.y << 16); f[3] = __uint_as_float(r.y & 0xffff0000u);
  f[4] = __uint_as_float(r.z << 16); f[5] = __uint_as_float(r.z & 0xffff0000u);
  f[6] = __uint_as_float(r.w << 16); f[7] = __uint_as_float(r.w & 0xffff0000u);
}
DI void unpack4(uint2 r, float* f) {
  f[0] = __uint_as_float(r.x << 16); f[1] = __uint_as_float(r.x & 0xffff0000u);
  f[2] = __uint_as_float(r.y << 16); f[3] = __uint_as_float(r.y & 0xffff0000u);
}
DI uint4 pack8u(const float* f) { return make_uint4(pack2(f[0], f[1]), pack2(f[2], f[3]), pack2(f[4], f[5]), pack2(f[6], f[7])); }
DI bf16x8 as_frag(uint4 v) { return __builtin_bit_cast(bf16x8, v); }
DI bf16x8 ldfrag(const u16* p) { return as_frag(*(const uint4*)p); }

DI float xr16_sum(float v) { const auto t = __builtin_amdgcn_permlane16_swap(__float_as_uint(v), __float_as_uint(v), false, false); return __uint_as_float(t[0]) + __uint_as_float(t[1]); }
DI float xr32_sum(float v) { const auto t = __builtin_amdgcn_permlane32_swap(__float_as_uint(v), __float_as_uint(v), false, false); return __uint_as_float(t[0]) + __uint_as_float(t[1]); }
DI float xr16_max(float v) { const auto t = __builtin_amdgcn_permlane16_swap(__float_as_uint(v), __float_as_uint(v), false, false); return fmaxf(__uint_as_float(t[0]), __uint_as_float(t[1])); }
DI float xr32_max(float v) { const auto t = __builtin_amdgcn_permlane32_swap(__float_as_uint(v), __float_as_uint(v), false, false); return fmaxf(__uint_as_float(t[0]), __uint_as_float(t[1])); }
DI float quad_sum(float v) { return xr32_sum(xr16_sum(v)); }
DI float quad_max(float v) { return xr32_max(xr16_max(v)); }
DI float wave_sum(float v) {
#pragma unroll
  for (int o = 8; o; o >>= 1) v += __shfl_xor(v, o);
  return quad_sum(v);
}
DI float sigmoidf_(float x) { return 1.f / (1.f + __expf(-x)); }

DI void conv_tile(const float* __restrict__ src, int K, int N, u16* __restrict__ dst, int tk, int tn, float* sm) {
  const int tid = otid();
  const int nn = tid & 63, kk = tid >> 6;
  const int n = tn * 64 + nn;
#pragma unroll
  for (int i = 0; i < 16; i++) {
    const int k = kk + 4 * i;
    sm[k * 65 + nn] = (n < N) ? src[(size_t)(tk * 64 + k) * N + n] : 0.f;
  }
  __syncthreads();
  const int on = tid >> 2, kq = (tid & 3) * 16;
  unsigned w[8];
#pragma unroll
  for (int j = 0; j < 8; j++) w[j] = pack2(sm[(kq + 2 * j) * 65 + on], sm[(kq + 2 * j + 1) * 65 + on]);
  uint4* d = (uint4*)(dst + (size_t)(tn * 64 + on) * K + tk * 64 + kq);
  d[0] = make_uint4(w[0], w[1], w[2], w[3]);
  d[1] = make_uint4(w[4], w[5], w[6], w[7]);
  __syncthreads();
}

DI void mod_task(const Params& p, int task, float* sm) {
  const int tid = otid();
  const int lm = task / 96, cgp = task % 96;
  float* s = sm;
  float* red = sm + 5 * 1024;
  for (int i = tid; i < 5 * 1024; i += 256) {
    const int r = i >> 10, k = i & 1023;
    const float v = (r < 4) ? p.in[IC][r * 1024 + k] : p.in[ICCTX][k];
    s[i] = v / (1.f + expf(-v));
  }
  __syncthreads();
  const int col = tid & 63, ks = tid >> 6;
  const int j = cgp * 64 + col;
  const float* w = p.in[IADAW] + (size_t)lm * 1024 * 6144 + j;
  float a0 = 0, a1 = 0, a2 = 0, a3 = 0, a4 = 0;
#pragma unroll 8
  for (int k = ks * 256; k < ks * 256 + 256; k++) {
    const float wv = w[(size_t)k * 6144];
    a0 += s[k] * wv; a1 += s[1024 + k] * wv; a2 += s[2048 + k] * wv; a3 += s[3072 + k] * wv; a4 += s[4096 + k] * wv;
  }
  red[(ks * 5 + 0) * 64 + col] = a0; red[(ks * 5 + 1) * 64 + col] = a1; red[(ks * 5 + 2) * 64 + col] = a2;
  red[(ks * 5 + 3) * 64 + col] = a3; red[(ks * 5 + 4) * 64 + col] = a4;
  __syncthreads();
  if (tid < 64) {
    float* mod = (float*)(p.ws + WS_MOD);
    const float bias = p.in[IADAB][lm * 6144 + cgp * 64 + tid];
#pragma unroll
    for (int r = 0; r < 5; r++) {
      float v = bias;
#pragma unroll
      for (int q = 0; q < 4; q++) v += red[(q * 5 + r) * 64 + tid];
      mod[(size_t)(lm * 5 + r) * 6144 + cgp * 64 + tid] = v;
    }
  }
  __syncthreads();
}

DI void conv_desc(const Params& p, int l, int t, const float*& src, u16*& dst, int& K, int& N, int& tk, int& tn) {
  constexpr int C1 = 16 * 108, C2 = C1 + 16 * 64, C3 = C2 + 64 * 16, C4 = C3 + 256, C5 = C4 + 256, C6 = C5 + 24, C7 = C6 + 16;
  const int s = (t >= C1) + (t >= C2) + (t >= C3) + (t >= C4) + (t >= C5) + (t >= C6) + (t >= C7);
  const int base = s == 0 ? 0 : s == 1 ? C1 : s == 2 ? C2 : s == 3 ? C3 : s == 4 ? C4 : s == 5 ? C5 : s == 6 ? C6 : C7;
  const int i = t - base;
  K = s == 2 ? DFF : s == 5 ? 256 : s == 6 ? 128 : s == 7 ? 64 : D;
  N = s == 0 ? DIN : s == 1 ? DFF : s == 5 ? 384 : s == 6 ? 512 : s == 7 ? 64 : D;
  const int ktiles_log2 = s == 2 ? 6 : s == 5 ? 2 : s == 6 ? 1 : s == 7 ? 0 : 4;
  tk = i & ((1 << ktiles_log2) - 1);
  tn = s == 7 ? 0 : (i >> ktiles_log2);
  const float* s0 = p.in[IWIN] + (size_t)l * D * DIN; const float* s1 = p.in[IWFF1] + (size_t)l * D * DFF; const float* s2 = p.in[IWFF2] + (size_t)l * D * DFF;
  const float* s3 = p.in[IWOUT] + (size_t)l * D * D; const float* s4 = p.in[IWBR] + (size_t)l * D * D; const float* s5 = p.in[IWQB] + (size_t)l * 256 * 384;
  const float* s6 = p.in[IWKVB] + (size_t)l * 128 * 512; const float* s7 = p.in[IPOOLW] + (size_t)(l * 4 + i) * 4096;
  src = s == 0 ? s0 : s == 1 ? s1 : s == 2 ? s2 : s == 3 ? s3 : s == 4 ? s4 : s == 5 ? s5 : s == 6 ? s6 : s7;
  const size_t off = s == 0 ? WS_WIN : s == 1 ? WS_WFF1 : s == 2 ? WS_WFF2 : s == 3 ? WS_WO : s == 4 ? WS_WBR : s == 5 ? WS_WQB : s == 6 ? WS_WKVB : (WS_WPOOL + (size_t)i * 8192);
  dst = (u16*)(p.ws + off);
}
#define CONV_LOAD(R, S_, N_, TK_, TN_) { const int n_ = (TN_) * 64 + nn; const float* s_ = (S_) + (size_t)((TK_) * 64 + kk) * (N_) + min(n_, (N_) - 1); const size_t st_ = (size_t)4 * (N_); \
  R##0 = s_[0]; R##1 = s_[st_]; R##2 = s_[2 * st_]; R##3 = s_[3 * st_]; R##4 = s_[4 * st_]; R##5 = s_[5 * st_]; R##6 = s_[6 * st_]; R##7 = s_[7 * st_]; \
  R##8 = s_[8 * st_]; R##9 = s_[9 * st_]; R##10 = s_[10 * st_]; R##11 = s_[11 * st_]; R##12 = s_[12 * st_]; R##13 = s_[13 * st_]; R##14 = s_[14 * st_]; R##15 = s_[15 * st_]; }
DI void phase_conv(const Params& p, int l, unsigned char* smem) {
  float* sm = (float*)smem;
  constexpr int NT = 16 * 108 + 16 * 64 + 64 * 16 + 256 + 256 + 24 + 16 + 4;
  const int tid = otid();
  const int nn = tid & 63, kk = tid >> 6;
  const int G = gridDim.x;
  if ((int)blockIdx.x < NT) {
    float c0, c1, c2, c3, c4, c5, c6, c7, c8, c9, c10, c11, c12, c13, c14, c15;
    float n0, n1, n2, n3, n4, n5, n6, n7, n8, n9, n10, n11, n12, n13, n14, n15;
    const float* csrc; u16* cdst; int cK, cN, ctk, ctn;
    conv_desc(p, l, blockIdx.x, csrc, cdst, cK, cN, ctk, ctn);
    CONV_LOAD(c, csrc, cN, ctk, ctn)
    for (int v = blockIdx.x; v < NT; v += G) {
      const float* nsrc; u16* ndst; int nK, nN, ntk, ntn;
      conv_desc(p, l, min(v + G, NT - 1), nsrc, ndst, nK, nN, ntk, ntn);
      CONV_LOAD(n, nsrc, nN, ntk, ntn)
      const bool inb = ctn * 64 + nn < cN;
      float* s = sm + kk * 65 + nn;
      s[0] = inb ? c0 : 0.f; s[4 * 65] = inb ? c1 : 0.f; s[8 * 65] = inb ? c2 : 0.f; s[12 * 65] = inb ? c3 : 0.f;
      s[16 * 65] = inb ? c4 : 0.f; s[20 * 65] = inb ? c5 : 0.f; s[24 * 65] = inb ? c6 : 0.f; s[28 * 65] = inb ? c7 : 0.f;
      s[32 * 65] = inb ? c8 : 0.f; s[36 * 65] = inb ? c9 : 0.f; s[40 * 65] = inb ? c10 : 0.f; s[44 * 65] = inb ? c11 : 0.f;
      s[48 * 65] = inb ? c12 : 0.f; s[52 * 65] = inb ? c13 : 0.f; s[56 * 65] = inb ? c14 : 0.f; s[60 * 65] = inb ? c15 : 0.f;
      __syncthreads();
      const int on = tid >> 2, kq = (tid & 3) * 16;
      unsigned w[8];
#pragma unroll
      for (int j = 0; j < 8; j++) w[j] = pack2(sm[(kq + 2 * j) * 65 + on], sm[(kq + 2 * j + 1) * 65 + on]);
      uint4* d = (uint4*)(cdst + (size_t)(ctn * 64 + on) * cK + ctk * 64 + kq);
      d[0] = make_uint4(w[0], w[1], w[2], w[3]);
      d[1] = make_uint4(w[4], w[5], w[6], w[7]);
      __syncthreads();
      csrc = nsrc; cdst = ndst; cK = nK; cN = nN; ctk = ntk; ctn = ntn;
      c0 = n0; c1 = n1; c2 = n2; c3 = n3; c4 = n4; c5 = n5; c6 = n6; c7 = n7; c8 = n8; c9 = n9; c10 = n10; c11 = n11; c12 = n12; c13 = n13; c14 = n14; c15 = n15;
    }
  }
  if (l == 0) {
    if (G == 512) { const int v = (int)blockIdx.x - 232; if (v >= 0 && v < 192) mod_task(p, v, sm); }
    else for (int v = blockIdx.x; v < 192; v += G) mod_task(p, v, sm);
  }
}

DI void phase_norm(const Params& p, int l, int half, int which, int b0 = 0, int nb = 0) {
  const int lane = otid() & 63, wave = otid() >> 6;
  const float* mod = (const float*)(p.ws + WS_MOD);
  const float* gain = p.in[which ? INORM2 : INORM1] + l * D;
  u16* H = (u16*)(p.ws + WS_H);
  if (nb == 0) nb = gridDim.x;
  if ((int)blockIdx.x < b0 || (int)blockIdx.x >= b0 + nb) return;
  auto src_of = [&](int r) -> const float* {
    const int bb = r / TB, t = r - bb * TB, b = half * 2 + bb;
    if (t < LAT) return ((which == 0 && l == 0) ? p.in[IX] : p.out) + ((size_t)b * LAT + t) * D;
    return ((which == 0 && l == 0) ? p.in[ICTX] : (const float*)(p.ws + WS_XC)) + ((size_t)b * CL + (t - LAT)) * D;
  };
  const int step = nb * 4;
  int r = ((int)blockIdx.x - b0) * 4 + wave;
  if (r >= RH) return;
  float4 n0, n1, n2, n3;
  { const float* s_ = src_of(r) + lane * 4; n0 = *(const float4*)(s_); n1 = *(const float4*)(s_ + 256); n2 = *(const float4*)(s_ + 512); n3 = *(const float4*)(s_ + 768); }
  for (; r < RH; r += step) {
    const int bb = r / TB, t = r - bb * TB, b = half * 2 + bb;
    float4 xv[4] = {n0, n1, n2, n3};
    { const float* s_ = src_of(r + step < RH ? r + step : r) + lane * 4; n0 = *(const float4*)(s_); n1 = *(const float4*)(s_ + 256); n2 = *(const float4*)(s_ + 512); n3 = *(const float4*)(s_ + 768); }
    if (t >= LAT && l == 1 && which == 1) continue;
    const float* mrow = mod + (size_t)(l * 5 + (t < LAT ? b : 4)) * 6144;
    const float* sh = mrow + (which ? 3 * D : 0);
    const float* sc = mrow + (which ? 4 * D : D);
    float ssq = 0;
#pragma unroll
    for (int i = 0; i < 4; i++) ssq += xv[i].x * xv[i].x + xv[i].y * xv[i].y + xv[i].z * xv[i].z + xv[i].w * xv[i].w;
    ssq = wave_sum(ssq);
    const float rinv = rsqrtf(ssq * (1.f / D) + EPS);
#pragma unroll
    for (int i = 0; i < 4; i++) {
      const int c = i * 256 + lane * 4;
      const float4 g = *(const float4*)(gain + c), s1 = *(const float4*)(sc + c), s0 = *(const float4*)(sh + c);
      const float y0 = xv[i].x * rinv * g.x * (1.f + s1.x) + s0.x;
      const float y1 = xv[i].y * rinv * g.y * (1.f + s1.y) + s0.y;
      const float y2 = xv[i].z * rinv * g.z * (1.f + s1.z) + s0.z;
      const float y3 = xv[i].w * rinv * g.w * (1.f + s1.w) + s0.w;
      *(uint2*)(H + (size_t)r * D + c) = make_uint2(pack2(y0, y1), pack2(y2, y3));
    }
  }
}

constexpr int LDT = 72;
#define GK_LOAD(P, a0, a1, a2, a3, b0, b1, b2, b3) \
  a0 = *(const uint4*)(ap + (P)); a1 = *(const uint4*)(ap + sa32 + (P)); a2 = *(const uint4*)(ap + 2 * sa32 + (P)); a3 = *(const uint4*)(ap + 3 * sa32 + (P)); \
  b0 = *(const uint4*)(bp + (P)); b1 = *(const uint4*)(bp + sb32 + (P)); b2 = *(const uint4*)(bp + 2 * sb32 + (P)); b3 = *(const uint4*)(bp + 3 * sb32 + (P));
#define GK_STORE(a0, a1, a2, a3, b0, b1, b2, b3) \
  *(uint4*)(wa) = a0; *(uint4*)(wa + 32 * LDT) = a1; *(uint4*)(wa + 64 * LDT) = a2; *(uint4*)(wa + 96 * LDT) = a3; \
  *(uint4*)(wb) = b0; *(uint4*)(wb + 32 * LDT) = b1; *(uint4*)(wb + 64 * LDT) = b2; *(uint4*)(wb + 96 * LDT) = b3;
#define GK_COMPUTE \
  _Pragma("unroll") for (int ks = 0; ks < 2; ks++) { \
    const bf16x8 a0 = ldfrag(fa + ks * 32), a1 = ldfrag(fa + 16 * LDT + ks * 32), a2 = ldfrag(fa + 32 * LDT + ks * 32), a3 = ldfrag(fa + 48 * LDT + ks * 32); \
    const bf16x8 b0 = ldfrag(fb + ks * 32), b1 = ldfrag(fb + 16 * LDT + ks * 32), b2 = ldfrag(fb + 32 * LDT + ks * 32), b3 = ldfrag(fb + 48 * LDT + ks * 32); \
    acc[0][0] = MFMA(b0, a0, acc[0][0]); acc[0][1] = MFMA(b1, a0, acc[0][1]); acc[0][2] = MFMA(b2, a0, acc[0][2]); acc[0][3] = MFMA(b3, a0, acc[0][3]); \
    acc[1][0] = MFMA(b0, a1, acc[1][0]); acc[1][1] = MFMA(b1, a1, acc[1][1]); acc[1][2] = MFMA(b2, a1, acc[1][2]); acc[1][3] = MFMA(b3, a1, acc[1][3]); \
    acc[2][0] = MFMA(b0, a2, acc[2][0]); acc[2][1] = MFMA(b1, a2, acc[2][1]); acc[2][2] = MFMA(b2, a2, acc[2][2]); acc[2][3] = MFMA(b3, a2, acc[2][3]); \
    acc[3][0] = MFMA(b0, a3, acc[3][0]); acc[3][1] = MFMA(b1, a3, acc[3][1]); acc[3][2] = MFMA(b2, a3, acc[3][2]); acc[3][3] = MFMA(b3, a3, acc[3][3]); \
  }
constexpr int GT = 128 * LDT;
#define GK_STORE2(O, a0, a1, a2, a3, b0, b1, b2, b3) \
  *(uint4*)(wa + (O)) = a0; *(uint4*)(wa + (O) + 32 * LDT) = a1; *(uint4*)(wa + (O) + 64 * LDT) = a2; *(uint4*)(wa + (O) + 96 * LDT) = a3; \
  *(uint4*)(wb + (O)) = b0; *(uint4*)(wb + (O) + 32 * LDT) = b1; *(uint4*)(wb + (O) + 64 * LDT) = b2; *(uint4*)(wb + (O) + 96 * LDT) = b3;
#define GK_COMPUTE2(O) \
  _Pragma("unroll") for (int ks = 0; ks < 2; ks++) { \
    const bf16x8 a0 = ldfrag(fa + (O) + ks * 32), a1 = ldfrag(fa + (O) + 16 * LDT + ks * 32), a2 = ldfrag(fa + (O) + 32 * LDT + ks * 32), a3 = ldfrag(fa + (O) + 48 * LDT + ks * 32); \
    const bf16x8 b0 = ldfrag(fb + (O) + ks * 32), b1 = ldfrag(fb + (O) + 16 * LDT + ks * 32), b2 = ldfrag(fb + (O) + 32 * LDT + ks * 32), b3 = ldfrag(fb + (O) + 48 * LDT + ks * 32); \
    acc[0][0] = MFMA(b0, a0, acc[0][0]); acc[0][1] = MFMA(b1, a0, acc[0][1]); acc[0][2] = MFMA(b2, a0, acc[0][2]); acc[0][3] = MFMA(b3, a0, acc[0][3]); \
    acc[1][0] = MFMA(b0, a1, acc[1][0]); acc[1][1] = MFMA(b1, a1, acc[1][1]); acc[1][2] = MFMA(b2, a1, acc[1][2]); acc[1][3] = MFMA(b3, a1, acc[1][3]); \
    acc[2][0] = MFMA(b0, a2, acc[2][0]); acc[2][1] = MFMA(b1, a2, acc[2][1]); acc[2][2] = MFMA(b2, a2, acc[2][2]); acc[2][3] = MFMA(b3, a2, acc[2][3]); \
    acc[3][0] = MFMA(b0, a3, acc[3][0]); acc[3][1] = MFMA(b1, a3, acc[3][1]); acc[3][2] = MFMA(b2, a3, acc[3][2]); acc[3][3] = MFMA(b3, a3, acc[3][3]); \
  }
template <bool DEEP>
DI void gemm_kloop(f32x4 (&acc)[4][4], const u16* __restrict__ A, int lda, const u16* __restrict__ B, int ldb, int K, u16* sA, u16* sB) {
  const int tid = otid(), lane = tid & 63, wave = tid >> 6;
  const int wm = wave >> 1, wn = wave & 1, l15 = lane & 15, quad = lane >> 4;
  const int crow = tid >> 3, ckc = (tid & 7) * 8;
  const u16* ap = A + (size_t)crow * lda + ckc;
  const u16* bp = B + (size_t)crow * ldb + ckc;
  const size_t sa32 = (size_t)32 * lda, sb32 = (size_t)32 * ldb;
  u16* wa = sA + crow * LDT + ckc;
  u16* wb = sB + crow * LDT + ckc;
  const u16* fa = sA + (wm * 64 + l15) * LDT + quad * 8;
  const u16* fb = sB + (wn * 64 + l15) * LDT + quad * 8;
  uint4 ra0, ra1, ra2, ra3, rb0, rb1, rb2, rb3;
  GK_LOAD(0, ra0, ra1, ra2, ra3, rb0, rb1, rb2, rb3)
  __syncthreads();
  GK_STORE2(0, ra0, ra1, ra2, ra3, rb0, rb1, rb2, rb3)
  if (DEEP) {
    uint4 sa0, sa1, sa2, sa3, sb0, sb1, sb2, sb3;
    GK_LOAD(64, ra0, ra1, ra2, ra3, rb0, rb1, rb2, rb3)
    { const int k2 = min(128, K - 64); GK_LOAD(k2, sa0, sa1, sa2, sa3, sb0, sb1, sb2, sb3) }
    for (int k0 = 0; k0 < K; k0 += 128) {
      __syncthreads();
      GK_COMPUTE2(0)
      GK_STORE2(2 * GT, ra0, ra1, ra2, ra3, rb0, rb1, rb2, rb3)
      { const int kn = min(k0 + 192, K - 64); GK_LOAD(kn, ra0, ra1, ra2, ra3, rb0, rb1, rb2, rb3) }
      __syncthreads();
      GK_COMPUTE2(2 * GT)
      GK_STORE2(0, sa0, sa1, sa2, sa3, sb0, sb1, sb2, sb3)
      { const int kn = min(k0 + 256, K - 64); GK_LOAD(kn, sa0, sa1, sa2, sa3, sb0, sb1, sb2, sb3) }
    }
  } else {
    for (int k0 = 0; k0 < K; k0 += 128) {
      __syncthreads();
      GK_LOAD(k0 + 64, ra0, ra1, ra2, ra3, rb0, rb1, rb2, rb3)
      GK_COMPUTE2(0)
      GK_STORE2(2 * GT, ra0, ra1, ra2, ra3, rb0, rb1, rb2, rb3)
      __syncthreads();
      if (k0 + 128 < K) { GK_LOAD(k0 + 128, ra0, ra1, ra2, ra3, rb0, rb1, rb2, rb3) }
      GK_COMPUTE2(2 * GT)
      if (k0 + 128 < K) { GK_STORE2(0, ra0, ra1, ra2, ra3, rb0, rb1, rb2, rb3) }
    }
  }
}

DI bool tile_map(int v, int TM, int TN, int& tm, int& tn) {
  const int T = TM * TN, per = (T + 7) >> 3;
  const int g = (v & 7) * per + (v >> 3);
  if (g >= T) return false;
  const int group = g / (8 * TN), fm = group * 8;
  const int gsz = min(8, TM - fm), r = g - group * 8 * TN;
  tm = fm + r % gsz; tn = r / gsz;
  return true;
}
DI int tile_count(int TM, int TN) { return ((TM * TN + 7) >> 3) * 8; }
DI bool is_ctx_tile(int tm) { return ((tm * 128) % TB) >= LAT; }

#define ZERO_ACC(acc) _Pragma("unroll") for (int _a = 0; _a < 4; _a++) _Pragma("unroll") for (int _b = 0; _b < 4; _b++) acc[_a][_b] = f32x4{0.f, 0.f, 0.f, 0.f};

#define EPI_COORDS \
  const int lane_ = otid() & 63, wave_ = otid() >> 6; \
  const int wm_ = wave_ >> 1, wn_ = wave_ & 1, l15_ = lane_ & 15, quad_ = lane_ >> 4;

DI void phase_gemm_in(const Params& p, int l, u16* sm) {
  const u16* H = (const u16*)(p.ws + WS_H); const u16* W = (const u16*)(p.ws + WS_WIN); u16* U = (u16*)(p.ws + WS_U);
  constexpr int TM = RH / 128, TN = NU / 128;
  constexpr int NLAT = 64 * TN, NCTX = 4 * 12;
  const int nv = (l == 1) ? (NLAT + NCTX) : tile_count(TM, TN);
  EPI_COORDS
  for (int v = blockIdx.x; v < nv; v += gridDim.x) {
    int tm, tn;
    if (l == 1) {
      if (v < NLAT) { if (!tile_map(v, 64, TN, tm, tn)) continue; tm += 2 * (tm >> 5); }
      else { const int i = v - NLAT; const int tc = i / 12; tn = i - tc * 12; tm = 34 * (tc >> 1) + 32 + (tc & 1); }
    } else if (!tile_map(v, TM, TN, tm, tn)) continue;
    f32x4 acc[4][4]; ZERO_ACC(acc)
    gemm_kloop<true>(acc, H + (size_t)tm * 128 * D, D, W + (size_t)tn * 128 * D, D, D, sm, sm + 128 * LDT);
#pragma unroll
    for (int mt = 0; mt < 4; mt++)
#pragma unroll
      for (int nt = 0; nt < 4; nt++) {
        const int row = tm * 128 + wm_ * 64 + mt * 16 + l15_, col = tn * 128 + wn_ * 64 + nt * 16 + quad_ * 4;
        f32x4 v = acc[mt][nt];
        if (tn >= U_GHG / 128 && col >= U_GHG) {
          v[0] = sigmoidf_(v[0]); v[1] = sigmoidf_(v[1]); v[2] = sigmoidf_(v[2]); v[3] = sigmoidf_(v[3]);
        }
        *(uint2*)(U + (size_t)row * NU + col) = make_uint2(pack2(v[0], v[1]), pack2(v[2], v[3]));
      }
  }
}

DI void phase_merge(const Params& p, int l, u16* sm) {
  const u16* Y = (const u16*)(p.ws + WS_Y); const u16* W = (const u16*)(p.ws + WS_WBR); const u16* U = (const u16*)(p.ws + WS_U);
  u16* Z = (u16*)(p.ws + WS_H);
  constexpr int TM = RH / 128, TN = D / 128;
  EPI_COORDS
  const int TMe = (l == 1) ? 64 : TM;
  for (int v = blockIdx.x; v < tile_count(TMe, TN); v += gridDim.x) {
    int tm, tn; if (!tile_map(v, TMe, TN, tm, tn)) continue;
    if (l == 1) tm += 2 * (tm >> 5);
    f32x4 tot[4][4]; ZERO_ACC(tot)
    for (int seg = 0; seg < 4; seg++) {
      f32x4 acc[4][4]; ZERO_ACC(acc)
      gemm_kloop<false>(acc, Y + (size_t)tm * 128 * D + seg * 256, D, W + (size_t)tn * 128 * D + seg * 256, D, 256, sm, sm + 128 * LDT);
#pragma unroll
      for (int mt = 0; mt < 4; mt++)
#pragma unroll
        for (int nt = 0; nt < 4; nt++) {
          const int row = tm * 128 + wm_ * 64 + mt * 16 + l15_, col = tn * 128 + wn_ * 64 + nt * 16 + quad_ * 4;
          float g[4]; unpack4(*(const uint2*)(U + (size_t)row * NU + U_GATE + seg * 1024 + col), g);
#pragma unroll
          for (int j = 0; j < 4; j++) tot[mt][nt][j] += g[j] * acc[mt][nt][j];
        }
    }
#pragma unroll
    for (int mt = 0; mt < 4; mt++)
#pragma unroll
      for (int nt = 0; nt < 4; nt++) {
        const int row = tm * 128 + wm_ * 64 + mt * 16 + l15_, col = tn * 128 + wn_ * 64 + nt * 16 + quad_ * 4;
        *(uint2*)(Z + (size_t)row * D + col) = make_uint2(pack2(tot[mt][nt][0], tot[mt][nt][1]), pack2(tot[mt][nt][2], tot[mt][nt][3]));
      }
  }
}

DI void phase_resid(const Params& p, int l, int half, int which, u16* sm) {
  const u16* A = (const u16*)(p.ws + (which ? WS_U : WS_H));
  const u16* W = (const u16*)(p.ws + (which ? WS_WFF2 : WS_WO));
  const int K = which ? DFF : D;
  const float* mod = (const float*)(p.ws + WS_MOD);
  float* xc = (float*)(p.ws + WS_XC);
  constexpr int TM = RH / 128, TN = D / 128;
  EPI_COORDS
  const int TMe = (l == 1) ? 64 : TM;
  for (int v = blockIdx.x; v < tile_count(TMe, TN); v += gridDim.x) {
    int tm, tn; if (!tile_map(v, TMe, TN, tm, tn)) continue;
    if (l == 1) tm += 2 * (tm >> 5);
    f32x4 acc[4][4]; ZERO_ACC(acc)
    gemm_kloop<true>(acc, A + (size_t)tm * 128 * K, K, W + (size_t)tn * 128 * K, K, K, sm, sm + 128 * LDT);
#pragma unroll
    for (int mt = 0; mt < 4; mt++) {
      const int row = tm * 128 + wm_ * 64 + mt * 16 + l15_;
      const int bb = row / TB, t = row - bb * TB, b = half * 2 + bb;
      const bool lat = t < LAT;
      const float* gate = mod + (size_t)(l * 5 + (lat ? b : 4)) * 6144 + (which ? 5 * D : 2 * D);
      const float* src; float* dst;
      if (lat) {
        dst = p.out + ((size_t)b * LAT + t) * D;
        src = (which == 0 && l == 0) ? p.in[IX] + ((size_t)b * LAT + t) * D : dst;
      } else {
        dst = xc + ((size_t)b * CL + (t - LAT)) * D;
        src = (which == 0 && l == 0) ? p.in[ICTX] + ((size_t)b * CL + (t - LAT)) * D : dst;
      }
#pragma unroll
      for (int nt = 0; nt < 4; nt++) {
        const int col = tn * 128 + wn_ * 64 + nt * 16 + quad_ * 4;
        const float4 g = *(const float4*)(gate + col);
        float4 x = *(const float4*)(src + col);
        x.x += g.x * acc[mt][nt][0]; x.y += g.y * acc[mt][nt][1]; x.z += g.z * acc[mt][nt][2]; x.w += g.w * acc[mt][nt][3];
        *(float4*)(dst + col) = x;
      }
    }
  }
}

DI void phase_ff1(const Params& p, int l, u16* sm) {
  const u16* H = (const u16*)(p.ws + WS_H); const u16* W = (const u16*)(p.ws + WS_WFF1); u16* F = (u16*)(p.ws + WS_U);
  constexpr int TM = RH / 128, TN = DFF / 128;
  EPI_COORDS
  const int TMe = (l == 1) ? 64 : TM;
  for (int v = blockIdx.x; v < tile_count(TMe, TN); v += gridDim.x) {
    int tm, tn; if (!tile_map(v, TMe, TN, tm, tn)) continue;
    if (l == 1) tm += 2 * (tm >> 5);
    f32x4 acc[4][4]; ZERO_ACC(acc)
    gemm_kloop<true>(acc, H + (size_t)tm * 128 * D, D, W + (size_t)tn * 128 * D, D, D, sm, sm + 128 * LDT);
#pragma unroll
    for (int mt = 0; mt < 4; mt++)
#pragma unroll
      for (int nt = 0; nt < 4; nt++) {
        const int row = tm * 128 + wm_ * 64 + mt * 16 + l15_, col = tn * 128 + wn_ * 64 + nt * 16 + quad_ * 4;
        float r[4];
#pragma unroll
        for (int j = 0; j < 4; j++) { const float x = fmaxf(acc[mt][nt][j], 0.f); r[j] = x * x; }
        *(uint2*)(F + (size_t)row * DFF + col) = make_uint2(pack2(r[0], r[1]), pack2(r[2], r[3]));
      }
  }
}

DI void head_norm_rope(f32x4 (&a)[6], const float* __restrict__ gain, bool rope, int t, int quad, float outscale) {
  float ssq = 0;
#pragma unroll
  for (int nt = 0; nt < 6; nt++)
#pragma unroll
    for (int j = 0; j < 4; j++) ssq += a[nt][j] * a[nt][j];
  ssq = quad_sum(ssq);
  const float rinv = rsqrtf(ssq * (1.f / 96.f) + EPS);
#pragma unroll
  for (int nt = 0; nt < 6; nt++) {
    const float4 g = *(const float4*)(gain + nt * 16 + quad * 4);
    a[nt][0] *= rinv * g.x; a[nt][1] *= rinv * g.y; a[nt][2] *= rinv * g.z; a[nt][3] *= rinv * g.w;
  }
#pragma unroll
  for (int ax = 0; ax < 2; ax++) {
    const float pos = (float)(ax == 0 ? (t >> 6) : (t & 63));
    const bool hi = (quad & 1) != 0, second = (quad & 2) != 0;
    const float c_lo[4] = {1.f, 0.31622776601683794f, 0.1f, 0.031622776601683794f};
    const float c_hi[4] = {0.01f, 0.0031622776601683794f, 0.001f, 0.00031622776601683794f};
#pragma unroll
    for (int j = 0; j < 4; j++) {
      const float mine = a[4 + ax][j];
      const float other = __shfl_xor(mine, 32);
      const float ang = pos * (hi ? c_hi[j] : c_lo[j]);
      const float cs = __cosf(ang), sn = __sinf(ang);
      const float r = second ? (mine * cs + other * sn) : (mine * cs - other * sn);
      if (rope) a[4 + ax][j] = r;
    }
  }
#pragma unroll
  for (int nt = 0; nt < 6; nt++)
#pragma unroll
    for (int j = 0; j < 4; j++) a[nt][j] *= outscale;
}

#define SCHED_FENCE
DI void prep_task(const Params& p, int l, int task) {
  const int lane = otid() & 63, l15 = lane & 15, quad = lane >> 4;
  const int h = task & 3;
  const int r0 = (task >> 2) * 64 + (otid() >> 6) * 16, row = r0 + l15;
  const int bb = r0 / TB, t0 = r0 - bb * TB, t = t0 + l15;
  const bool lat = t0 < LAT;
  const u16* U = (const u16*)(p.ws + WS_U);
  const u16* urow = U + (size_t)row * NU;
  const u16* Wq = (const u16*)(p.ws + WS_WQB);
  const u16* Wkv = (const u16*)(p.ws + WS_WKVB);
  u16* Qm = (u16*)(p.ws + WS_QM); u16* Km = (u16*)(p.ws + WS_KM); u16* VTm = (u16*)(p.ws + WS_VTM);
  u16* Qn = (u16*)(p.ws + WS_QN); u16* Kn = (u16*)(p.ws + WS_KN); u16* VTn = (u16*)(p.ws + WS_VTN);

  uint4 rq[8], rk[4]; uint2 rr[2];
#pragma unroll
  for (int ks = 0; ks < 8; ks++) rq[ks] = *(const uint4*)(urow + U_QA + ks * 32 + quad * 8);
#pragma unroll
  for (int ks = 0; ks < 4; ks++) rk[ks] = *(const uint4*)(urow + U_KVA + ks * 32 + quad * 8);
#pragma unroll
  for (int tt = 0; tt < 2; tt++) rr[tt] = *(const uint2*)(urow + U_KVA + 128 + tt * 16 + quad * 4);
  bf16x8 wf[16];
#pragma unroll
  for (int ks = 0; ks < 8; ks++) wf[ks] = ldfrag(Wq + (size_t)(h * 96 + l15) * 256 + quad * 8 + ks * 32);
  SCHED_FENCE;

  bf16x8 afq[8];
  {
    float ssq = 0;
#pragma unroll
    for (int ks = 0; ks < 8; ks++) {
      float v[8]; unpack8(rq[ks], v);
#pragma unroll
      for (int j = 0; j < 8; j++) ssq += v[j] * v[j];
    }
    ssq = quad_sum(ssq);
    const float rinv = rsqrtf(ssq * (1.f / 256.f) + EPS);
    const float* g = p.in[IQNORM] + l * 256;
#pragma unroll
    for (int ks = 0; ks < 8; ks++) {
      float v[8]; unpack8(rq[ks], v);
      const float4 g0 = *(const float4*)(g + ks * 32 + quad * 8), g1 = *(const float4*)(g + ks * 32 + quad * 8 + 4);
      float o[8] = {v[0] * rinv * g0.x, v[1] * rinv * g0.y, v[2] * rinv * g0.z, v[3] * rinv * g0.w,
                    v[4] * rinv * g1.x, v[5] * rinv * g1.y, v[6] * rinv * g1.z, v[7] * rinv * g1.w};
      afq[ks] = as_frag(pack8u(o));
    }
  }
  f32x4 qa[6];
#pragma unroll
  for (int nt = 0; nt < 6; nt++) {
    const int cur = (nt & 1) * 8, nxt = 8 - cur;
    if (nt < 5) {
#pragma unroll
      for (int ks = 0; ks < 8; ks++) wf[nxt + ks] = ldfrag(Wq + (size_t)(h * 96 + (nt + 1) * 16 + l15) * 256 + quad * 8 + ks * 32);
    }
    SCHED_FENCE;
    qa[nt] = f32x4{0.f, 0.f, 0.f, 0.f};
#pragma unroll
    for (int ks = 0; ks < 8; ks++) qa[nt] = MFMA(wf[cur + ks], afq[ks], qa[nt]);
    SCHED_FENCE;
  }
#pragma unroll
  for (int nt = 0; nt < 4; nt++)
#pragma unroll
    for (int ks = 0; ks < 4; ks++) wf[nt * 4 + ks] = ldfrag(Wkv + (size_t)(h * 128 + nt * 16 + l15) * 128 + quad * 8 + ks * 32);
  SCHED_FENCE;
  bf16x8 afk[4];
  {
    float ssq = 0;
#pragma unroll
    for (int ks = 0; ks < 4; ks++) {
      float v[8]; unpack8(rk[ks], v);
#pragma unroll
      for (int j = 0; j < 8; j++) ssq += v[j] * v[j];
    }
    ssq = quad_sum(ssq);
    const float rinv = rsqrtf(ssq * (1.f / 128.f) + EPS);
    const float* g = p.in[IKVNORM] + l * 128;
#pragma unroll
    for (int ks = 0; ks < 4; ks++) {
      float v[8]; unpack8(rk[ks], v);
      const float4 g0 = *(const float4*)(g + ks * 32 + quad * 8), g1 = *(const float4*)(g + ks * 32 + quad * 8 + 4);
      float o[8] = {v[0] * rinv * g0.x, v[1] * rinv * g0.y, v[2] * rinv * g0.z, v[3] * rinv * g0.w,
                    v[4] * rinv * g1.x, v[5] * rinv * g1.y, v[6] * rinv * g1.z, v[7] * rinv * g1.w};
      afk[ks] = as_frag(pack8u(o));
    }
  }
  f32x4 ka[6];
#pragma unroll
  for (int nt = 0; nt < 4; nt++) {
    ka[nt] = f32x4{0.f, 0.f, 0.f, 0.f};
#pragma unroll
    for (int ks = 0; ks < 4; ks++) ka[nt] = MFMA(wf[nt * 4 + ks], afk[ks], ka[nt]);
  }
  SCHED_FENCE;
#pragma unroll
  for (int nt = 0; nt < 4; nt++)
#pragma unroll
    for (int ks = 0; ks < 4; ks++) wf[nt * 4 + ks] = ldfrag(Wkv + (size_t)(h * 128 + 64 + nt * 16 + l15) * 128 + quad * 8 + ks * 32);
  uint4 nq[2], nk[2]; u16 ev[16];
#pragma unroll
  for (int i = 0; i < 2; i++) { nq[i] = *(const uint4*)(urow + U_QNA + h * 64 + quad * 16 + i * 8); nk[i] = *(const uint4*)(urow + U_KNA + h * 64 + quad * 16 + i * 8); }
#pragma unroll
  for (int nt = 0; nt < 4; nt++)
#pragma unroll
    for (int j = 0; j < 4; j++) ev[nt * 4 + j] = U[(size_t)(r0 + quad * 4 + j) * NU + U_VNA + h * 64 + nt * 16 + l15];
  SCHED_FENCE;
  head_norm_rope(qa, p.in[IGQ] + l * 96, lat, t, quad, 0.14724444602590306f  );
#pragma unroll
  for (int nt = 0; nt < 6; nt++)
    *(uint2*)(Qm + (size_t)row * 512 + h * 128 + nt * 16 + quad * 4) = make_uint2(pack2(qa[nt][0], qa[nt][1]), pack2(qa[nt][2], qa[nt][3]));
#pragma unroll
  for (int tt = 0; tt < 2; tt++) {
    float kr[4]; unpack4(rr[tt], kr);
    ka[4 + tt] = f32x4{kr[0], kr[1], kr[2], kr[3]};
  }
  head_norm_rope(ka, p.in[IGK] + l * 96, lat, t, quad, 1.f);
#pragma unroll
  for (int nt = 0; nt < 6; nt++)
    *(uint2*)(Km + (size_t)row * 512 + h * 128 + nt * 16 + quad * 4) = make_uint2(pack2(ka[nt][0], ka[nt][1]), pack2(ka[nt][2], ka[nt][3]));
#pragma unroll
  for (int nt = 0; nt < 4; nt++) {
    f32x4 va = f32x4{0.f, 0.f, 0.f, 0.f};
#pragma unroll
    for (int ks = 0; ks < 4; ks++) va = MFMA(afk[ks], wf[nt * 4 + ks], va);
    *(uint2*)(VTm + ((size_t)(bb * 4 + h) * 64 + nt * 16 + l15) * TB + t0 + quad * 4) = make_uint2(pack2(va[0], va[1]), pack2(va[2], va[3]));
  }
#pragma unroll
  for (int qk = 0; qk < 2; qk++) {
    const float* g = p.in[qk ? INAGK : INAGQ] + l * 64 + quad * 16;
    float v[16];
    unpack8(qk ? nk[0] : nq[0], v); unpack8(qk ? nk[1] : nq[1], v + 8);
    float ssq = 0;
#pragma unroll
    for (int j = 0; j < 16; j++) ssq += v[j] * v[j];
    ssq = quad_sum(ssq);
    const float rinv = rsqrtf(ssq * (1.f / 64.f) + EPS) * (qk ? 1.f : 0.18033688011112042f  );
#pragma unroll
    for (int j = 0; j < 16; j++) v[j] *= rinv * g[j];
    u16* dst = (qk ? Kn : Qn) + (size_t)row * 256 + h * 64 + quad * 16;
    *(uint4*)dst = pack8u(v); *(uint4*)(dst + 8) = pack8u(v + 8);
  }
#pragma unroll
  for (int nt = 0; nt < 4; nt++)
    *(uint2*)(VTn + ((size_t)(bb * 4 + h) * 64 + nt * 16 + l15) * TB + t0 + quad * 4) =
        make_uint2((unsigned)ev[nt * 4] | ((unsigned)ev[nt * 4 + 1] << 16), (unsigned)ev[nt * 4 + 2] | ((unsigned)ev[nt * 4 + 3] << 16));
}

DI float lb_val(const Params& p, int l, int dir, int ch) {
  const float* a = p.in[IHGLB];
  const float a0 = a[(0 * 2 + dir) * 256 + ch], a1 = a[(1 * 2 + dir) * 256 + ch], a2 = a[(2 * 2 + dir) * 256 + ch];
  const float mx = fmaxf(a0, fmaxf(a1, a2));
  const float e0 = __expf(a0 - mx), e1 = __expf(a1 - mx), e2 = __expf(a2 - mx);
  const float inv = 1.f / (e0 + e1 + e2);
  const float v = (l == 0) ? e0 * inv : (e0 + e1) * inv;
  return fminf(fmaxf(v, 1e-6f), 1.f - 1e-6f);
}

DI void hg1_task(const Params& p, int l, int task, unsigned char* smem) {
  const int tid = otid(), d = tid & 63, seg = tid >> 6;
  const int seq = task / 68, s = task - seq * 68;
  const int bb = seq >> 3, h = (seq >> 1) & 3, dir = seq & 1;
  u16* KT = (u16*)smem; u16* IT = KT + 64 * LDT; float* tot = (float*)(IT + 64 * LDT);
  const u16* U = (const u16*)(p.ws + WS_U);
  const bool isctx = s < 4;
  const int cpos = (isctx ? s : s - 4) * 64;
  const float lb = lb_val(p, l, dir, h * 64 + d);
  float kk[16], bc[16]; u16 iv[16], zr[16]; float run = 0;
#pragma unroll
  for (int e = 0; e < 16; e++) {
    const int pos = cpos + seg * 16 + e;
    const int t = isctx ? (LAT + (dir ? 255 - pos : pos)) : (dir ? 4095 - pos : pos);
    const u16* ur = U + (size_t)(bb * TB + t) * NU;
    zr[e] = ur[U_ZF + dir * 256 + h * 64 + d];
    iv[e] = ur[U_I + h * 64 + d];
  }
  asm volatile("" ::: "memory");
#pragma unroll
  for (int e = 0; e < 16; e++) {
    const float z = bf2f(zr[e]);
    const float sg = __builtin_amdgcn_rcpf(1.f + __expf(z));
    kk[e] = (1.f - lb) * sg;
    run += __logf(1.f - kk[e]);
    bc[e] = run;
  }
  tot[seg * 64 + d] = run;
  __syncthreads();
  float pre = 0, bl = 0;
#pragma unroll
  for (int q = 0; q < 4; q++) { const float tv = tot[q * 64 + d]; if (q < seg) pre += tv; bl += tv; }
  {
    float o[16];
#pragma unroll
    for (int e = 0; e < 16; e++) o[e] = kk[e] * __expf(bl - (pre + bc[e]));
    *(uint4*)(KT + d * LDT + seg * 16) = pack8u(o); *(uint4*)(KT + d * LDT + seg * 16 + 8) = pack8u(o + 8);
    uint4 i0 = make_uint4(iv[0] | ((unsigned)iv[1] << 16), iv[2] | ((unsigned)iv[3] << 16), iv[4] | ((unsigned)iv[5] << 16), iv[6] | ((unsigned)iv[7] << 16));
    uint4 i1 = make_uint4(iv[8] | ((unsigned)iv[9] << 16), iv[10] | ((unsigned)iv[11] << 16), iv[12] | ((unsigned)iv[13] << 16), iv[14] | ((unsigned)iv[15] << 16));
    *(uint4*)(IT + d * LDT + seg * 16) = i0; *(uint4*)(IT + d * LDT + seg * 16 + 8) = i1;
  }
  if (seg == 0) ((float*)(p.ws + WS_DEC))[(size_t)(seq * 68 + s) * 64 + d] = __expf(bl);
  __syncthreads();
  {
    const int lane = tid & 63, w = seg, l15 = lane & 15, quad = lane >> 4;
    f32x4 acc[4];
#pragma unroll
    for (int nt = 0; nt < 4; nt++) acc[nt] = f32x4{0.f, 0.f, 0.f, 0.f};
#pragma unroll
    for (int ks = 0; ks < 2; ks++) {
      const bf16x8 a = ldfrag(KT + (w * 16 + l15) * LDT + ks * 32 + quad * 8);
#pragma unroll
      for (int nt = 0; nt < 4; nt++) acc[nt] = MFMA(a, ldfrag(IT + (nt * 16 + l15) * LDT + ks * 32 + quad * 8), acc[nt]);
    }
    float* S = (float*)(p.ws + WS_S) + (size_t)(seq * 68 + s) * 4096;
#pragma unroll
    for (int nt = 0; nt < 4; nt++)
#pragma unroll
      for (int j = 0; j < 4; j++) S[(w * 16 + quad * 4 + j) * 64 + nt * 16 + l15] = acc[nt][j];
  }
  __syncthreads();
}

DI void hg2_task(const Params& p, int task) {
  const int idx = task * 256 + otid();
  const int seq = idx >> 12, e = idx & 4095, d = e >> 6;
  float* S = (float*)(p.ws + WS_S) + (size_t)seq * 68 * 4096 + e;
  const float* dec = (const float*)(p.ws + WS_DEC) + (size_t)seq * 68 * 64 + d;
  float st = 0.f;
  for (int s0 = 0; s0 < 68; s0 += 17) {
    float tmp[17], dc[17];
#pragma unroll
    for (int j = 0; j < 17; j++) { tmp[j] = S[(size_t)(s0 + j) * 4096]; dc[j] = dec[(s0 + j) * 64]; }
#pragma unroll
    for (int j = 0; j < 17; j++) { S[(size_t)(s0 + j) * 4096] = st; st = dc[j] * st + tmp[j]; }
  }
}

DI void hg3_task(const Params& p, int l, int task, unsigned char* smem) {
  const int tid = otid(), d = tid & 63, seg = tid >> 6;
  const int lane = tid & 63, w = seg, l15 = lane & 15, quad = lane >> 4;
  int bb, h, c, base; bool isctx;
  if (task < 512) { bb = task >> 8; h = (task >> 6) & 3; c = task & 63; base = c * 64; isctx = false; }
  else { const int q = task - 512; bb = q >> 4; h = (q >> 2) & 3; c = q & 3; base = LAT + c * 64; isctx = true; }
  u16* QT = (u16*)smem; u16* KT = QT + 64 * LDT; u16* QE = KT + 64 * LDT; u16* IT = QE + 64 * LDT; u16* ST = IT + 64 * LDT;
  float* O = (float*)(ST + 64 * LDT); float* tot = O + 64 * 64;
  const u16* U = (const u16*)(p.ws + WS_U);
  for (int dir = 0; dir < 2; dir++) {
    const int s = isctx ? (dir ? 3 - c : c) : (dir ? 4 + 63 - c : 4 + c);
    const int seq = (bb * 4 + h) * 2 + dir;
    const float lb = lb_val(p, l, dir, h * 64 + d);
    float kk[16], bc[16], qv[16]; u16 iv[16], zr[16], qr[16]; float sv[16]; float run = 0;
#pragma unroll
    for (int e = 0; e < 16; e++) {
      const int i = seg * 16 + e;
      const int tl = dir ? 63 - i : i;
      const u16* ur = U + (size_t)(bb * TB + base + tl) * NU;
      zr[e] = ur[U_ZF + dir * 256 + h * 64 + d];
      qr[e] = ur[U_QHG + h * 64 + d];
      iv[e] = ur[U_I + h * 64 + d];
    }
    {
      const float* Sg = (const float*)(p.ws + WS_S) + (size_t)(seq * 68 + s) * 4096;
#pragma unroll
      for (int e = 0; e < 16; e++) sv[e] = Sg[(seg * 16 + e) * 64 + d];
    }
    asm volatile("" ::: "memory");
#pragma unroll
    for (int e = 0; e < 16; e++) {
      const float z = bf2f(zr[e]);
      qv[e] = bf2f(qr[e]) * 0.125f;
      const float sg = __builtin_amdgcn_rcpf(1.f + __expf(z));
      kk[e] = (1.f - lb) * sg;
      run += __logf(1.f - kk[e]);
      bc[e] = run;
    }
    tot[seg * 64 + d] = run;
    __syncthreads();
    float pre = 0;
#pragma unroll
    for (int q = 0; q < 4; q++) { const float tv = tot[q * 64 + d]; if (q < seg) pre += tv; }
    const float bm = tot[d] + tot[64 + d];
#pragma unroll
    for (int e = 0; e < 16; e++) {
      const int i = seg * 16 + e;
      const float b = pre + bc[e];
      QT[i * LDT + d] = f2bf(qv[e] * __expf(b - bm));
      KT[i * LDT + d] = f2bf(kk[e] * __expf(bm - b));
      QE[i * LDT + d] = f2bf(qv[e] * __expf(b));
    }
    {
      uint4 i0 = make_uint4(iv[0] | ((unsigned)iv[1] << 16), iv[2] | ((unsigned)iv[3] << 16), iv[4] | ((unsigned)iv[5] << 16), iv[6] | ((unsigned)iv[7] << 16));
      uint4 i1 = make_uint4(iv[8] | ((unsigned)iv[9] << 16), iv[10] | ((unsigned)iv[11] << 16), iv[12] | ((unsigned)iv[13] << 16), iv[14] | ((unsigned)iv[15] << 16));
      *(uint4*)(IT + d * LDT + seg * 16) = i0; *(uint4*)(IT + d * LDT + seg * 16 + 8) = i1;
      *(uint4*)(ST + d * LDT + seg * 16) = pack8u(sv); *(uint4*)(ST + d * LDT + seg * 16 + 8) = pack8u(sv + 8);
    }
    __syncthreads();
    f32x4 am[4];
#pragma unroll
    for (int nt = 0; nt < 4; nt++) am[nt] = f32x4{0.f, 0.f, 0.f, 0.f};
#pragma unroll
    for (int ks = 0; ks < 2; ks++) {
      const bf16x8 a = ldfrag(QT + (w * 16 + l15) * LDT + ks * 32 + quad * 8);
#pragma unroll
      for (int nt = 0; nt < 4; nt++) am[nt] = MFMA(a, ldfrag(KT + (nt * 16 + l15) * LDT + ks * 32 + quad * 8), am[nt]);
    }
    __syncthreads();
#pragma unroll
    for (int nt = 0; nt < 4; nt++)
#pragma unroll
      for (int j = 0; j < 4; j++) {
        const int tt = w * 16 + quad * 4 + j, ss = nt * 16 + l15;
        QT[tt * LDT + ss] = (ss <= tt) ? f2bf(am[nt][j]) : (u16)0;
      }
    __syncthreads();
    f32x4 o[4];
#pragma unroll
    for (int nt = 0; nt < 4; nt++) o[nt] = f32x4{0.f, 0.f, 0.f, 0.f};
#pragma unroll
    for (int ks = 0; ks < 2; ks++) {
      const bf16x8 a = ldfrag(QT + (w * 16 + l15) * LDT + ks * 32 + quad * 8);
      const bf16x8 a2 = ldfrag(QE + (w * 16 + l15) * LDT + ks * 32 + quad * 8);
#pragma unroll
      for (int nt = 0; nt < 4; nt++) {
        o[nt] = MFMA(a, ldfrag(IT + (nt * 16 + l15) * LDT + ks * 32 + quad * 8), o[nt]);
        o[nt] = MFMA(a2, ldfrag(ST + (nt * 16 + l15) * LDT + ks * 32 + quad * 8), o[nt]);
      }
    }
#pragma unroll
    for (int nt = 0; nt < 4; nt++)
#pragma unroll
      for (int j = 0; j < 4; j++) {
        const int i = w * 16 + quad * 4 + j;
        const int tl = dir ? 63 - i : i;
        if (dir == 0) O[tl * 64 + nt * 16 + l15] = o[nt][j]; else O[tl * 64 + nt * 16 + l15] += o[nt][j];
      }
    __syncthreads();
  }
  {
    const int tl = tid >> 2, vq = (tid & 3) * 16;
    const size_t row = (size_t)(bb * TB + base + tl);
    float ov[16]; float ssq = 0;
#pragma unroll
    for (int j = 0; j < 16; j++) { ov[j] = O[tl * 64 + vq + j]; ssq += ov[j] * ov[j]; }
    ssq += __shfl_xor(ssq, 1); ssq += __shfl_xor(ssq, 2);
    const float rinv = rsqrtf(ssq * (1.f / 64.f) + EPS);
    float g[16];
    unpack8(*(const uint4*)(U + row * NU + U_GHG + h * 64 + vq), g); unpack8(*(const uint4*)(U + row * NU + U_GHG + h * 64 + vq + 8), g + 8);
    const float* gn = p.in[IHGNORM] + l * 64 + vq;
#pragma unroll
    for (int j = 0; j < 16; j++) ov[j] = ov[j] * rinv * gn[j] * g[j];
    u16* dst = (u16*)(p.ws + WS_Y) + row * D + 768 + h * 64 + vq;
    *(uint4*)dst = pack8u(ov); *(uint4*)(dst + 8) = pack8u(ov + 8);
  }
  __syncthreads();
}

DI void pool_task(const Params& p, int l, int task, unsigned char* smem) {
  const int tid = otid(), lane = tid & 63, g = tid >> 6, l15 = lane & 15, quad = lane >> 4;
  int bb, tt, Ls, rowbase;
  if (task < 128) { bb = task >> 6; tt = task & 63; Ls = LAT; rowbase = bb * TB; }
  else { const int q = task - 128; bb = q >> 2; tt = q & 3; Ls = CL; rowbase = bb * TB + LAT; }
  constexpr int PS = 264;
  u16* PU = (u16*)smem;
  const u16* U = (const u16*)(p.ws + WS_U);
  const int t0 = tt * 64;
  for (int c = tid; c < 80 * 32; c += 256) {
    const int r = c >> 5, cc = (c & 31) * 8;
    const int pos = t0 - 8 + r;
    uint4 val = make_uint4(0, 0, 0, 0);
    if (pos >= 0 && pos < Ls) val = *(const uint4*)(U + (size_t)(rowbase + pos) * NU + U_POOL + cc);
    *(uint4*)(PU + r * PS + cc) = val;
  }
  __syncthreads();
  const int w = 2 << g, hw = w >> 1;
  const u16* Wt = (const u16*)(p.ws + WS_WPOOL) + g * 4096;
  f32x4 acc[4][4]; ZERO_ACC(acc)
#pragma unroll
  for (int mt = 0; mt < 4; mt++) {
    const int tloc = mt * 16 + l15, pos = t0 + tloc;
    const int lo = max(pos - hw, 0), hi = min(pos - hw + w, Ls);
    const float inv = 1.f / (float)(hi - lo);
#pragma unroll
    for (int ks = 0; ks < 2; ks++) {
      const int chb = g * 64 + ks * 32 + quad * 8;
      float sum[8] = {0, 0, 0, 0, 0, 0, 0, 0};
      for (int r = 0; r < w; r++) {
        float f[8]; unpack8(*(const uint4*)(PU + (tloc + 8 - hw + r) * PS + chb), f);
#pragma unroll
        for (int j = 0; j < 8; j++) sum[j] += f[j];
      }
      float self[8]; unpack8(*(const uint4*)(PU + (tloc + 8) * PS + chb), self);
#pragma unroll
      for (int j = 0; j < 8; j++) sum[j] = sum[j] * inv - self[j];
      const bf16x8 pf = as_frag(pack8u(sum));
#pragma unroll
      for (int nt = 0; nt < 4; nt++) acc[mt][nt] = MFMA(ldfrag(Wt + (nt * 16 + l15) * 64 + ks * 32 + quad * 8), pf, acc[mt][nt]);
    }
  }
  u16* Y = (u16*)(p.ws + WS_Y);
#pragma unroll
  for (int mt = 0; mt < 4; mt++)
#pragma unroll
    for (int nt = 0; nt < 4; nt++) {
      const int e0 = nt * 16 + quad * 4;
      const float4 sc = *(const float4*)(p.in[IPOOLS] + l * 256 + g * 64 + e0);
      const size_t row = (size_t)(rowbase + t0 + mt * 16 + l15);
      *(uint2*)(Y + row * D + g * 64 + e0) = make_uint2(pack2(acc[mt][nt][0] * sc.x, acc[mt][nt][1] * sc.y), pack2(acc[mt][nt][2] * sc.z, acc[mt][nt][3] * sc.w));
    }
  __syncthreads();
}

template <int NKS> struct KVStage { bf16x8 kf[2][NKS]; bf16x8 vf[4]; };
template <int NKS>
DI void kv_load(KVStage<NKS>& s, const u16* __restrict__ Kp, int ldk, const u16* __restrict__ VT, int kbase, int l15, int quad) {
#pragma unroll
  for (int kt = 0; kt < 2; kt++)
#pragma unroll
    for (int ks = 0; ks < NKS; ks++) s.kf[kt][ks] = ldfrag(Kp + (size_t)(kbase + kt * 16 + l15) * ldk + ks * 32 + quad * 8);
#pragma unroll
  for (int dt = 0; dt < 4; dt++) {
    const u16* vp = VT + (size_t)(dt * 16 + l15) * TB + kbase + quad * 4;
    const uint2 lo = *(const uint2*)vp, hi = *(const uint2*)(vp + 16);
    s.vf[dt] = as_frag(make_uint4(lo.x, lo.y, hi.x, hi.y));
  }
}

template <int DQK, int NQT, bool NA>
DI void attn_block(const u16* __restrict__ Q, int ldq, const u16* __restrict__ Kp, int ldk, const u16* __restrict__ VT,
                   u16* __restrict__ Yp, int q0, int kb, int nblk, int r, const float* rpb_s) {
  constexpr int NKS = DQK / 32;
  const int lane = otid() & 63, w = otid() >> 6, l15 = lane & 15, quad = lane >> 4;
  const int qrow0 = q0 + w * 16 * NQT;
  bf16x8 qf[NQT][NKS];
#pragma unroll
  for (int qt = 0; qt < NQT; qt++)
#pragma unroll
    for (int ks = 0; ks < NKS; ks++) qf[qt][ks] = ldfrag(Q + (size_t)(qrow0 + qt * 16 + l15) * ldq + ks * 32 + quad * 8);
  f32x4 o[NQT][4]; float m[NQT], lsum[NQT];
#pragma unroll
  for (int qt = 0; qt < NQT; qt++) {
    m[qt] = -1e30f; lsum[qt] = 0.f;
#pragma unroll
    for (int dt = 0; dt < 4; dt++) o[qt][dt] = f32x4{0.f, 0.f, 0.f, 0.f};
  }
  const int rs = NA ? min(max(r - 4, 0), 56) : 0;
  const int kscol = NA ? (w == 0 ? 0 : (w == 1 ? 8 : (w == 2 ? 24 : 32))) : 0;
  const int qc = w * 16 + l15;
  const int cs = min(max(qc - 8, 0), 48);
  auto kbase_of = [&](int blk) -> int {
    if (NA) return (blk < 8) ? ((rs + blk) * 64 + kscol) : (LAT + (blk - 8) * 32);
    return kb + blk * 32;
  };
  auto compute = [&](const KVStage<NKS>& st, int blk) {
#pragma unroll
    for (int qt = 0; qt < NQT; qt++) {
      f32x4 s0 = f32x4{0.f, 0.f, 0.f, 0.f}, s1 = f32x4{0.f, 0.f, 0.f, 0.f};
#pragma unroll
      for (int ks = 0; ks < NKS; ks++) { s0 = MFMA(st.kf[0][ks], qf[qt][ks], s0); s1 = MFMA(st.kf[1][ks], qf[qt][ks], s1); }
      if (NA && blk < 8) {
        const int dr = rs + blk - r + 7;
#pragma unroll
        for (int j = 0; j < 4; j++) {
          const int kc0 = kscol + quad * 4 + j, kc1 = kc0 + 16;
          const bool v0 = (kc0 >= cs) && (kc0 < cs + 16), v1 = (kc1 >= cs) && (kc1 < cs + 16);
          s0[j] = v0 ? s0[j] + rpb_s[dr * 31 + (kc0 - qc + 15)] : -1e30f;
          s1[j] = v1 ? s1[j] + rpb_s[dr * 31 + (kc1 - qc + 15)] : -1e30f;
        }
      }
      float mx = fmaxf(fmaxf(fmaxf(s0[0], s0[1]), fmaxf(s0[2], s0[3])), fmaxf(fmaxf(s1[0], s1[1]), fmaxf(s1[2], s1[3])));
      mx = quad_max(mx);
      const float mnew = fmaxf(m[qt], mx);
      if (__builtin_amdgcn_ballot_w64(mnew != m[qt]) != 0ull) {
        const float alpha = __builtin_amdgcn_exp2f(m[qt] - mnew);
        lsum[qt] *= alpha;
#pragma unroll
        for (int dt = 0; dt < 4; dt++) { o[qt][dt][0] *= alpha; o[qt][dt][1] *= alpha; o[qt][dt][2] *= alpha; o[qt][dt][3] *= alpha; }
        m[qt] = mnew;
      }
      float pv[8]; float ps = 0;
#pragma unroll
      for (int j = 0; j < 4; j++) { pv[j] = __builtin_amdgcn_exp2f(s0[j] - mnew); pv[4 + j] = __builtin_amdgcn_exp2f(s1[j] - mnew); }
#pragma unroll
      for (int j = 0; j < 8; j++) ps += pv[j];
      lsum[qt] += ps;
      const bf16x8 pf = as_frag(pack8u(pv));
#pragma unroll
      for (int dt = 0; dt < 4; dt++) o[qt][dt] = MFMA(st.vf[dt], pf, o[qt][dt]);
    }
  };
  KVStage<NKS> sa, sb;
  kv_load(sa, Kp, ldk, VT, kbase_of(0), l15, quad);
  kv_load(sb, Kp, ldk, VT, kbase_of(1), l15, quad);
  for (int blk = 0; blk < nblk; blk += 2) {
    compute(sa, blk);
    if (blk + 2 < nblk) kv_load(sa, Kp, ldk, VT, kbase_of(blk + 2), l15, quad);
    compute(sb, blk + 1);
    if (blk + 3 < nblk) kv_load(sb, Kp, ldk, VT, kbase_of(blk + 3), l15, quad);
  }
#pragma unroll
  for (int qt = 0; qt < NQT; qt++) {
    const float inv = 1.f / quad_sum(lsum[qt]);
    u16* yr = Yp + (size_t)(qrow0 + qt * 16 + l15) * D;
#pragma unroll
    for (int dt = 0; dt < 4; dt++)
      *(uint2*)(yr + dt * 16 + quad * 4) = make_uint2(pack2(o[qt][dt][0] * inv, o[qt][dt][1] * inv), pack2(o[qt][dt][2] * inv, o[qt][dt][3] * inv));
  }
}

constexpr int KS_LD = 104, VS_LD = 72;
constexpr int KS_TILE = 64 * KS_LD, VS_TILE = 64 * VS_LD;
template <int NQT>
DI void attn_mla_lds(const u16* __restrict__ Q, const u16* __restrict__ Kp, const u16* __restrict__ VT, u16* __restrict__ Yp,
                     int q0, int kb, int ntile, u16* sm) {
  constexpr int NKS = 3, ldq = 512, ldk = 512;
  const int tid = otid(), lane = tid & 63, w = tid >> 6, l15 = lane & 15, quad = lane >> 4;
  const int qrow0 = q0 + w * 16 * NQT;
  u16* Ks = sm;
  u16* Vs = sm + 2 * KS_TILE;
  bf16x8 qf[NQT][NKS];
#pragma unroll
  for (int qt = 0; qt < NQT; qt++)
#pragma unroll
    for (int ks = 0; ks < NKS; ks++) qf[qt][ks] = ldfrag(Q + (size_t)(qrow0 + qt * 16 + l15) * ldq + ks * 32 + quad * 8);
  f32x4 o[NQT][4]; float m[NQT], lsum[NQT];
#pragma unroll
  for (int qt = 0; qt < NQT; qt++) {
    m[qt] = -1e30f; lsum[qt] = 0.f;
#pragma unroll
    for (int dt = 0; dt < 4; dt++) o[qt][dt] = f32x4{0.f, 0.f, 0.f, 0.f};
  }
  const int kc0 = tid, kc1 = tid + 256, kc2 = tid + 512;
  const int kg0 = (kc0 / 12) * ldk + (kc0 % 12) * 8, kg1 = (kc1 / 12) * ldk + (kc1 % 12) * 8, kg2 = (kc2 / 12) * ldk + (kc2 % 12) * 8;
  const int kl0 = (kc0 / 12) * KS_LD + (kc0 % 12) * 8, kl1 = (kc1 / 12) * KS_LD + (kc1 % 12) * 8, kl2 = (kc2 / 12) * KS_LD + (kc2 % 12) * 8;
  const int vc0 = tid, vc1 = tid + 256;
  const size_t vg0 = (size_t)(vc0 >> 3) * TB + (vc0 & 7) * 8, vg1 = (size_t)(vc1 >> 3) * TB + (vc1 & 7) * 8;
  const int vl0 = (vc0 >> 3) * VS_LD + (vc0 & 7) * 8, vl1 = (vc1 >> 3) * VS_LD + (vc1 & 7) * 8;
  uint4 rk0, rk1, rk2, rv0, rv1;
  {
    const u16* kp = Kp + (size_t)kb * ldk; const u16* vp = VT + kb;
    rk0 = *(const uint4*)(kp + kg0); rk1 = *(const uint4*)(kp + kg1); rk2 = *(const uint4*)(kp + kg2);
    rv0 = *(const uint4*)(vp + vg0); rv1 = *(const uint4*)(vp + vg1);
  }
  __syncthreads();
  *(uint4*)(Ks + kl0) = rk0; *(uint4*)(Ks + kl1) = rk1; *(uint4*)(Ks + kl2) = rk2;
  *(uint4*)(Vs + vl0) = rv0; *(uint4*)(Vs + vl1) = rv1;
  __syncthreads();
  for (int t = 0; t < ntile; t++) {
    const int cur = t & 1;
    if (t + 1 < ntile) {
      const u16* kp = Kp + (size_t)(kb + (t + 1) * 64) * ldk; const u16* vp = VT + kb + (t + 1) * 64;
      rk0 = *(const uint4*)(kp + kg0); rk1 = *(const uint4*)(kp + kg1); rk2 = *(const uint4*)(kp + kg2);
      rv0 = *(const uint4*)(vp + vg0); rv1 = *(const uint4*)(vp + vg1);
    }
    const u16* ks_ = Ks + cur * KS_TILE; const u16* vs_ = Vs + cur * VS_TILE;
#pragma unroll
    for (int sub = 0; sub < 2; sub++) {
      bf16x8 kf[2][NKS], vf[4];
#pragma unroll
      for (int kt = 0; kt < 2; kt++)
#pragma unroll
        for (int ks = 0; ks < NKS; ks++) kf[kt][ks] = ldfrag(ks_ + (sub * 32 + kt * 16 + l15) * KS_LD + ks * 32 + quad * 8);
#pragma unroll
      for (int dt = 0; dt < 4; dt++) {
        const u16* vp = vs_ + (dt * 16 + l15) * VS_LD + sub * 32 + quad * 4;
        const uint2 lo = *(const uint2*)vp, hi = *(const uint2*)(vp + 16);
        vf[dt] = as_frag(make_uint4(lo.x, lo.y, hi.x, hi.y));
      }
#pragma unroll
      for (int qt = 0; qt < NQT; qt++) {
        f32x4 s0 = f32x4{0.f, 0.f, 0.f, 0.f}, s1 = f32x4{0.f, 0.f, 0.f, 0.f};
#pragma unroll
        for (int ks = 0; ks < NKS; ks++) { s0 = MFMA(kf[0][ks], qf[qt][ks], s0); s1 = MFMA(kf[1][ks], qf[qt][ks], s1); }
        float mx = fmaxf(fmaxf(fmaxf(s0[0], s0[1]), fmaxf(s0[2], s0[3])), fmaxf(fmaxf(s1[0], s1[1]), fmaxf(s1[2], s1[3])));
        mx = quad_max(mx);
        const float mnew = fmaxf(m[qt], mx);
        if (__builtin_amdgcn_ballot_w64(mnew != m[qt]) != 0ull) {
          const float alpha = __builtin_amdgcn_exp2f(m[qt] - mnew);
          lsum[qt] *= alpha;
#pragma unroll
          for (int dt = 0; dt < 4; dt++) { o[qt][dt][0] *= alpha; o[qt][dt][1] *= alpha; o[qt][dt][2] *= alpha; o[qt][dt][3] *= alpha; }
          m[qt] = mnew;
        }
        float pv[8]; float ps = 0;
#pragma unroll
        for (int j = 0; j < 4; j++) { pv[j] = __builtin_amdgcn_exp2f(s0[j] - mnew); pv[4 + j] = __builtin_amdgcn_exp2f(s1[j] - mnew); }
#pragma unroll
        for (int j = 0; j < 8; j++) ps += pv[j];
        lsum[qt] += ps;
        const bf16x8 pf = as_frag(pack8u(pv));
#pragma unroll
        for (int dt = 0; dt < 4; dt++) o[qt][dt] = MFMA(vf[dt], pf, o[qt][dt]);
      }
    }
    if (t + 1 < ntile) {
      u16* kd = Ks + (cur ^ 1) * KS_TILE; u16* vd = Vs + (cur ^ 1) * VS_TILE;
      *(uint4*)(kd + kl0) = rk0; *(uint4*)(kd + kl1) = rk1; *(uint4*)(kd + kl2) = rk2;
      *(uint4*)(vd + vl0) = rv0; *(uint4*)(vd + vl1) = rv1;
    }
    __syncthreads();
  }
#pragma unroll
  for (int qt = 0; qt < NQT; qt++) {
    const float inv = 1.f / quad_sum(lsum[qt]);
    u16* yr = Yp + (size_t)(qrow0 + qt * 16 + l15) * D;
#pragma unroll
    for (int dt = 0; dt < 4; dt++)
      *(uint2*)(yr + dt * 16 + quad * 4) = make_uint2(pack2(o[qt][dt][0] * inv, o[qt][dt][1] * inv), pack2(o[qt][dt][2] * inv, o[qt][dt][3] * inv));
  }
}

DI void phase_c(const Params& p, int l, unsigned char* smem) {
  constexpr int NPREP = RH / 16, NHG1 = 16 * 68;
  const int npool = 128 + (l == 0 ? 8 : 0);
  const int G = gridDim.x, bid = blockIdx.x;
  for (int v = bid; v < NHG1; v += G) hg1_task(p, l, v, smem);
  for (int v = (bid + G - (NHG1 % G)) % G; v < NPREP; v += G) prep_task(p, l, v);
  for (int v = (bid + 2 * G - (NHG1 % G) - (NPREP % G)) % G; v < npool; v += G) pool_task(p, l, v, smem);
}

DI void phase_d_task(const Params& p, int l, int t, unsigned char* smem) {
  const u16* Qm = (const u16*)(p.ws + WS_QM); const u16* Km = (const u16*)(p.ws + WS_KM); const u16* VTm = (const u16*)(p.ws + WS_VTM);
  const u16* Qn = (const u16*)(p.ws + WS_QN); const u16* Kn = (const u16*)(p.ws + WS_KN); const u16* VTn = (const u16*)(p.ws + WS_VTN);
  u16* Y = (u16*)(p.ws + WS_Y);
  float* rpb_s = (float*)smem;
  if (t < 256) {
    const int bb = t >> 7, h = (t >> 5) & 3, qb = t & 31;
    attn_mla_lds<2>(Qm + (size_t)bb * TB * 512 + h * 128, Km + (size_t)bb * TB * 512 + h * 128,
                    VTm + (size_t)(bb * 4 + h) * 64 * TB, Y + (size_t)bb * TB * D + 256 + h * 64, qb * 128, 0, TB / 64, (u16*)(smem + 2048));
    return;
  }
  t -= 256;
  if (t < 256) { hg2_task(p, t); return; }
  t -= 256;
  if (t < 512) {
    const int bb = t >> 8, h = (t >> 6) & 3, r = t & 63;
    __syncthreads();
    for (int i = otid(); i < 15 * 31; i += 256) rpb_s[i] = p.in[IRPB][(size_t)(l * 4 + h) * 465 + i] * 1.4426950408889634f;
    __syncthreads();
    attn_block<64, 1, true>(Qn + (size_t)bb * TB * 256 + h * 64, 256, Kn + (size_t)bb * TB * 256 + h * 64, 256,
                            VTn + (size_t)(bb * 4 + h) * 64 * TB, Y + (size_t)bb * TB * D + 512 + h * 64, r * 64, 0, 16, r, rpb_s);
    return;
  }
  t -= 512;
  if (t < 16) {
    const int bb = t >> 3, h = (t >> 1) & 3, qb = t & 1;
    attn_mla_lds<2>(Qm + (size_t)bb * TB * 512 + h * 128, Km + (size_t)bb * TB * 512 + h * 128,
                    VTm + (size_t)(bb * 4 + h) * 64 * TB, Y + (size_t)bb * TB * D + 256 + h * 64, LAT + qb * 128, LAT, CL / 64, (u16*)(smem + 2048));
    return;
  }
  t -= 16;
  {
    const int bb = t >> 3, h = (t >> 1) & 3, qb = t & 1;
    attn_block<64, 2, false>(Qn + (size_t)bb * TB * 256 + h * 64, 256, Kn + (size_t)bb * TB * 256 + h * 64, 256,
                             VTn + (size_t)(bb * 4 + h) * 64 * TB, Y + (size_t)bb * TB * D + 512 + h * 64, LAT + qb * 128, LAT, CL / 32, 0, nullptr);
  }
}

DI void phase_d(const Params& p, int l, unsigned char* smem) {
  const int G = gridDim.x, b = blockIdx.x;
  if (G == 512) {
    if (b < 256) { phase_d_task(p, l, b, smem); }
    else {
      const int r = b - 256;
      phase_d_task(p, l, 256 + r, smem);
      phase_d_task(p, l, 512 + r, smem);
      phase_d_task(p, l, 768 + r, smem);
      if (l == 0 && r < 32) phase_d_task(p, l, 1024 + r, smem);
    }
  } else {
    const int total = 256 + 256 + 512 + (l == 0 ? 32 : 0);
    for (int v = b; v < total; v += G) phase_d_task(p, l, v, smem);
  }
}

DI void phase_e(const Params& p, int l, unsigned char* smem) {
  const int total = 512 + (l == 0 ? 32 : 0);
  for (int v = blockIdx.x; v < total; v += gridDim.x) hg3_task(p, l, v, smem);
}


#define XB_TMO      128
#define XB_XCNT(j)  (256  + 64 * (j))
#define XB_XSUB(j)  (1280 + 64 * (j))
#define XB_XGEN(j)  (2304 + 64 * (j))
#define XB_TOP      3328
#define XB_TOPGEN   3392
#define XCD_BAR_WORDS 3456
#define XB_SPIN_CAP (1u << 20)
#define LAS __attribute__((address_space(3)))
DI unsigned xb_ld(unsigned* p) { return __hip_atomic_load(p, __ATOMIC_RELAXED, __HIP_MEMORY_SCOPE_AGENT); }
DI unsigned xb_add(unsigned* p, unsigned v) { return __hip_atomic_fetch_add(p, v, __ATOMIC_RELAXED, __HIP_MEMORY_SCOPE_AGENT); }
DI unsigned xb_xcc_id() { return (unsigned)__builtin_amdgcn_s_getreg((3 << 11) | 20) & 0xFu; }
#define XB_SPIN(cond, bar) do { unsigned _sp = 0; while (cond) { __builtin_amdgcn_s_sleep(1); \
    if ((++_sp & 255u) == 0u) { if (xb_ld(&(bar)[XB_TMO])) break; if (_sp > XB_SPIN_CAP) { atomicAdd(&(bar)[XB_TMO], 1u); break; } } } } while (0)
struct XcdBarrier { unsigned* bar; unsigned x; volatile LAS unsigned* st; };
DI XcdBarrier xcd_barrier_post(unsigned* bar, volatile LAS unsigned* st) {
  XcdBarrier b; b.bar = bar; b.x = xb_xcc_id(); b.st = st;
  if (threadIdx.x == 0) (void)xb_add(&bar[XB_XCNT(b.x)], 1u);
  return b;
}
DI void xcd_barrier_complete(unsigned* bar, unsigned x, unsigned& nloc, unsigned& nx) {
  const unsigned G = gridDim.x * gridDim.y * gridDim.z;
  unsigned sum, cnt, mine, sp = 0u;
  for (;;) {
    sum = 0u; cnt = 0u; mine = 0u;
#pragma unroll
    for (unsigned j = 0; j < 16; ++j) { const unsigned c = xb_ld(&bar[XB_XCNT(j)]); sum += c; cnt += (c > 0u) ? 1u : 0u; mine = (j == x) ? c : mine; }
    if (sum == G) break;
    __builtin_amdgcn_s_sleep(1);
    if ((++sp & 255u) == 0u) { if (xb_ld(&bar[XB_TMO])) break; if (sp > XB_SPIN_CAP) { atomicAdd(&bar[XB_TMO], 1u); break; } }
  }
  nloc = mine > 0u ? mine : 1u; nx = cnt > 0u ? cnt : 1u;
}
DI void xcd_barrier(const XcdBarrier& b) {
  asm volatile("s_waitcnt vmcnt(0)" ::: "memory");
  __syncthreads();
  if (threadIdx.x == 0) {
    unsigned* bar = b.bar;
    __builtin_amdgcn_s_waitcnt(0);
    unsigned nloc = b.st[0], nx = b.st[1];
    if (nloc == 0u) { xcd_barrier_complete(bar, b.x, nloc, nx); b.st[0] = nloc; b.st[1] = nx; }
    const unsigned old = xb_add(&bar[XB_XSUB(b.x)], 1u);
    const unsigned gen = old / nloc;
    if (old + 1u == (gen + 1u) * nloc) {
      __builtin_amdgcn_fence(__ATOMIC_RELEASE, "agent");
      asm volatile("s_waitcnt vmcnt(0)" ::: "memory");
      const unsigned og = xb_add(&bar[XB_TOP], 1u);
      const unsigned tg = og / nx;
      if (og + 1u == (tg + 1u) * nx) xb_add(&bar[XB_TOPGEN], 1u);
      else XB_SPIN(xb_ld(&bar[XB_TOPGEN]) == tg, bar);
      __builtin_amdgcn_fence(__ATOMIC_ACQUIRE, "agent");
      xb_add(&bar[XB_XGEN(b.x)], 1u);
      asm volatile("s_waitcnt vmcnt(0)" ::: "memory");
    } else {
      XB_SPIN(xb_ld(&bar[XB_XGEN(b.x)]) == gen, bar);
      __builtin_amdgcn_fence(__ATOMIC_ACQUIRE, "agent");
      asm volatile("s_waitcnt vmcnt(0)" ::: "memory");
    }
  }
  __syncthreads();
}

constexpr int LDS_BYTES = 4 * 128 * LDT * 2 + 16;
__global__ void __launch_bounds__(256, 2) mega(Params p, int ph_lo, int ph_hi) {
  cg::grid_group grid = cg::this_grid();
  extern __shared__ __attribute__((aligned(16))) unsigned char smem[];
  u16* sm16 = (u16*)smem;
  volatile LAS unsigned* xst = (volatile LAS unsigned*)(smem + LDS_BYTES - 16);
  if (threadIdx.x == 0) { xst[0] = 0u; xst[1] = 0u; }
  __syncthreads();
  const XcdBarrier xb = xcd_barrier_post((unsigned*)(p.ws + WS_BAR), xst);
  for (int ph = ph_lo; ph < ph_hi; ph++) {
    const int l = ph / 21, q = ph - l * 21;
    const int half = (q == 0) ? 0 : (q - 1) / 10;
    const int k = (q == 0) ? -1 : (q - 1) % 10;
    if (k == 0 && (l | half)) continue;
    switch (k) {
      case -1: phase_conv(p, l, smem); break;
      case 0: phase_norm(p, l, half, 0); break;
      case 1: phase_gemm_in(p, l, sm16); break;
      case 2: phase_c(p, l, smem); break;
      case 3: phase_d(p, l, smem); break;
      case 4: phase_e(p, l, smem); break;
      case 5: phase_merge(p, l, sm16); break;
      case 6: phase_resid(p, l, half, 0, sm16); break;
      case 7: phase_norm(p, l, half, 1); break;
      case 8: phase_ff1(p, l, sm16); break;
      default:
        phase_resid(p, l, half, 1, sm16);
        if (half == 0) phase_norm(p, l, 1, 0, (l == 0 && gridDim.x == 512) ? 32 : 0, (l == 0 && gridDim.x == 512) ? 480 : 0);
        else if (l == 0) phase_norm(p, 1, 0, 0, (gridDim.x == 512) ? 32 : 0, (gridDim.x == 512) ? 480 : 0);
        break;
    }
    if (ph + 1 < ph_hi) {
      if (ph_lo < 0) { asm volatile("s_waitcnt vmcnt(0)" ::: "memory"); grid.sync(); }
      xcd_barrier(xb);
    }
  }
}

extern "C" void kernel_launch(void* const* d_in, const int* in_sizes, int n_in, void* d_out, int out_size, void* d_ws,
                              size_t ws_size, hipStream_t stream) {
  static int grid_blocks = 0;
  if (!grid_blocks) {
    int dev = 0, cus = 0, per_cu = 0;
    hipGetDevice(&dev);
    hipDeviceGetAttribute(&cus, hipDeviceAttributeMultiprocessorCount, dev);
    hipFuncSetAttribute((const void*)mega, hipFuncAttributeMaxDynamicSharedMemorySize, LDS_BYTES);
    hipOccupancyMaxActiveBlocksPerMultiprocessor(&per_cu, mega, 256, LDS_BYTES);
    if (per_cu < 1) per_cu = 1;
    if (per_cu > 2) per_cu = 2;
    grid_blocks = cus * per_cu;
    if (ws_size < WS_END) fprintf(stderr, "kernel_launch: workspace too small: %zu < %zu\n", ws_size, (size_t)WS_END);
    if (n_in != NIN) fprintf(stderr, "kernel_launch: expected %d inputs, got %d\n", (int)NIN, n_in);
  }
  Params p{};
  for (int i = 0; i < NIN; i++) p.in[i] = (const float*)d_in[i];
  p.out = (float*)d_out;
  p.ws = (unsigned char*)d_ws;
  int ph_lo = 0, ph_hi = 42;
  hipMemsetAsync((unsigned char*)d_ws + WS_BAR, 0, XCD_BAR_WORDS * 4, stream);
  void* args[] = {&p, &ph_lo, &ph_hi};
  hipError_t e = hipLaunchCooperativeKernel((void*)mega, dim3(grid_blocks), dim3(256), args, LDS_BYTES, stream);
  if (e != hipSuccess) fprintf(stderr, "cooperative launch failed: %s (grid %d)\n", hipGetErrorString(e), grid_blocks);
}
```

```cpp
#include <hip/hip_runtime.h>
#include <hip/hip_cooperative_groups.h>
#include <cstdio>
namespace cg = cooperative_groups;

typedef unsigned short u16;
typedef __attribute__((ext_vector_type(8))) short bf16x8;
typedef __attribute__((ext_vector_type(4))) float f32x4;
#define DI __device__ __forceinline__
#define MFMA(a, b, c) __builtin_amdgcn_mfma_f32_16x16x32_bf16((a), (b), (c), 0, 0, 0)

constexpr int D = 1024, LAT = 4096, CL = 256, TB = LAT + CL;
constexpr int RH = 2 * TB;
constexpr int NU = 6912;
constexpr int DIN = 6816, DFF = 4096;
constexpr float EPS = 1e-6f;
constexpr int U_KVA = 0, U_KNA = 160, U_VNA = 416, U_ZF = 672, U_I = 1184, U_POOL = 1440, U_QA = 1696,
              U_QNA = 1952, U_QHG = 2208, U_GHG = 2464, U_GATE = 2720;
enum { IX = 0, IC, ICTX, ICCTX, IADAW, IADAB, INORM1, INORM2, IWIN, IPOOLW, IPOOLS, IQNORM, IWQB, IKVNORM, IWKVB,
       IGQ, IGK, INAGQ, INAGK, IRPB, IHGLB, IHGNORM, IWBR, IWOUT, IWFF1, IWFF2, NIN };

constexpr size_t al256(size_t x) { return (x + 255) & ~(size_t)255; }
constexpr size_t WS_MOD  = 0;
constexpr size_t WS_XC   = al256(WS_MOD + (size_t)2 * 5 * 6144 * 4);
constexpr size_t WS_WIN  = al256(WS_XC + (size_t)4 * CL * D * 4);
constexpr size_t WS_WFF1 = al256(WS_WIN + (size_t)NU * D * 2);
constexpr size_t WS_WFF2 = al256(WS_WFF1 + (size_t)DFF * D * 2);
constexpr size_t WS_WO   = al256(WS_WFF2 + (size_t)DFF * D * 2);
constexpr size_t WS_WBR  = al256(WS_WO + (size_t)D * D * 2);
constexpr size_t WS_WQB  = al256(WS_WBR + (size_t)D * D * 2);
constexpr size_t WS_WKVB = al256(WS_WQB + (size_t)384 * 256 * 2);
constexpr size_t WS_WPOOL= al256(WS_WKVB + (size_t)512 * 128 * 2);
constexpr size_t WS_H    = al256(WS_WPOOL + (size_t)4 * 64 * 64 * 2);
constexpr size_t WS_U    = al256(WS_H + (size_t)RH * D * 2);
constexpr size_t WS_QM   = al256(WS_U + (size_t)RH * NU * 2);
constexpr size_t WS_KM   = al256(WS_QM + (size_t)RH * 512 * 2);
constexpr size_t WS_VTM  = al256(WS_KM + (size_t)RH * 512 * 2);
constexpr size_t WS_QN   = al256(WS_VTM + (size_t)2 * 4 * 64 * TB * 2);
constexpr size_t WS_KN   = al256(WS_QN + (size_t)RH * 256 * 2);
constexpr size_t WS_VTN  = al256(WS_KN + (size_t)RH * 256 * 2);
constexpr size_t WS_Y    = al256(WS_VTN + (size_t)2 * 4 * 64 * TB * 2);
constexpr size_t WS_S    = al256(WS_Y + (size_t)RH * D * 2);
constexpr size_t WS_DEC  = al256(WS_S + (size_t)16 * 68 * 4096 * 4);
constexpr size_t WS_BAR  = al256(WS_DEC + (size_t)16 * 68 * 64 * 4);
constexpr size_t WS_END  = al256(WS_BAR + (size_t)3456 * 4);

struct Params {
  const float* in[NIN];
  float* out;
  unsigned char* ws;
};

DI int otid() { int t = threadIdx.x; asm volatile("" : "+v"(t)); return t; }
typedef __bf16 bf16v2 __attribute__((ext_vector_type(2)));
DI u16 f2bf(float x) { return __builtin_bit_cast(u16, (__bf16)x); }
DI float bf2f(u16 h) { return __uint_as_float(((unsigned)h) << 16); }
DI unsigned pack2(float a, float b) { bf16v2 v; v[0] = (__bf16)a; v[1] = (__bf16)b; return __builtin_bit_cast(unsigned, v); }
DI void unpack8(uint4 r, float* f) {
  f[0] = __uint_as_float(r.x << 16); f[1] = __uint_as_float(r.x & 0xffff0000u);
  f[2] = __uint_as_float(r.y << 16); f[3] = __uint_as_float(r.y & 0xffff0000u);
  f[4] = __uint_as_float(r.z << 16); f[5] = __uint_as_float(r.z & 0xffff0000u);
  f[6] = __uint_as_float(r.w << 16); f[7] = __uint_as_float(r.w & 0xffff0000u);
}
DI void unpack4(uint2 r, float* f) {
  f[0] = __uint_as_float(r.x << 16); f[1] = __uint_as_float(r.x & 0xffff0000u);
  f[2] = __uint_as_float(r.y << 16); f[3] = __uint_as_float(r.y & 0xffff0000u);
}
DI uint4 pack8u(const float* f) { return make_uint4(pack2(f[0], f[1]), pack2(f[2], f[3]), pack2(f[4], f[5]), pack2(f[6], f[7])); }
DI bf16x8 as_frag(uint4 v) { return __builtin_bit_cast(bf16x8, v); }
DI bf16x8 ldfrag(const u16* p) { return as_frag(*(const uint4*)p); }

DI float xr16_sum(float v) { const auto t = __builtin_amdgcn_permlane16_swap(__float_as_uint(v), __float_as_uint(v), false, false); return __uint_as_float(t[0]) + __uint_as_float(t[1]); }
DI float xr32_sum(float v) { const auto t = __builtin_amdgcn_permlane32_swap(__float_as_uint(v), __float_as_uint(v), false, false); return __uint_as_float(t[0]) + __uint_as_float(t[1]); }
DI float xr16_max(float v) { const auto t = __builtin_amdgcn_permlane16_swap(__float_as_uint(v), __float_as_uint(v), false, false); return fmaxf(__uint_as_float(t[0]), __uint_as_float(t[1])); }
DI float xr32_max(float v) { const auto t = __builtin_amdgcn_permlane32_swap(__float_as_uint(v), __float_as_uint(v), false, false); return fmaxf(__uint_as_float(t[0]), __uint_as_float(t[1])); }
DI float quad_sum(float v) { return xr32_sum(xr16_sum(v)); }
DI float quad_max(float v) { return xr32_max(xr16_max(v)); }
DI float wave_sum(float v) {
#pragma unroll
  for (int o = 8; o; o >>= 1) v += __shfl_xor(v, o);
  return quad_sum(v);
}
DI float sigmoidf_(float x) { return 1.f / (1.f + __expf(-x)); }

DI void conv_tile(const float* __restrict__ src, int K, int N, u16* __restrict__ dst, int tk, int tn, float* sm) {
  const int tid = otid();
  const int nn = tid & 63, kk = tid >> 6;
  const int n = tn * 64 + nn;
#pragma unroll
  for (int i = 0; i < 16; i++) {
    const int k = kk + 4 * i;
    sm[k * 65 + nn] = (n < N) ? src[(size_t)(tk * 64 + k) * N + n] : 0.f;
  }
  __syncthreads();
  const int on = tid >> 2, kq = (tid & 3) * 16;
  unsigned w[8];
#pragma unroll
  for (int j = 0; j < 8; j++) w[j] = pack2(sm[(kq + 2 * j) * 65 + on], sm[(kq + 2 * j + 1) * 65 + on]);
  uint4* d = (uint4*)(dst + (size_t)(tn * 64 + on) * K + tk * 64 + kq);
  d[0] = make_uint4(w[0], w[1], w[2], w[3]);
  d[1] = make_uint4(w[4], w[5], w[6], w[7]);
  __syncthreads();
}

DI void mod_task(const Params& p, int task, float* sm) {
  const int tid = otid();
  const int lm = task / 96, cgp = task % 96;
  float* s = sm;
  float* red = sm + 5 * 1024;
  for (int i = tid; i < 5 * 1024; i += 256) {
    const int r = i >> 10, k = i & 1023;
    const float v = (r < 4) ? p.in[IC][r * 1024 + k] : p.in[ICCTX][k];
    s[i] = v / (1.f + expf(-v));
  }
  __syncthreads();
  const int col = tid & 63, ks = tid >> 6;
  const int j = cgp * 64 + col;
  const float* w = p.in[IADAW] + (size_t)lm * 1024 * 6144 + j;
  float a0 = 0, a1 = 0, a2 = 0, a3 = 0, a4 = 0;
#pragma unroll 8
  for (int k = ks * 256; k < ks * 256 + 256; k++) {
    const float wv = w[(size_t)k * 6144];
    a0 += s[k] * wv; a1 += s[1024 + k] * wv; a2 += s[2048 + k] * wv; a3 += s[3072 + k] * wv; a4 += s[4096 + k] * wv;
  }
  red[(ks * 5 + 0) * 64 + col] = a0; red[(ks * 5 + 1) * 64 + col] = a1; red[(ks * 5 + 2) * 64 + col] = a2;
  red[(ks * 5 + 3) * 64 + col] = a3; red[(ks * 5 + 4) * 64 + col] = a4;
  __syncthreads();
  if (tid < 64) {
    float* mod = (float*)(p.ws + WS_MOD);
    const float bias = p.in[IADAB][lm * 6144 + cgp * 64 + tid];
#pragma unroll
    for (int r = 0; r < 5; r++) {
      float v = bias;
#pragma unroll
      for (int q = 0; q < 4; q++) v += red[(q * 5 + r) * 64 + tid];
      mod[(size_t)(lm * 5 + r) * 6144 + cgp * 64 + tid] = v;
    }
  }
  __syncthreads();
}

DI void conv_desc(const Params& p, int l, int t, const float*& src, u16*& dst, int& K, int& N, int& tk, int& tn) {
  constexpr int C1 = 16 * 108, C2 = C1 + 16 * 64, C3 = C2 + 64 * 16, C4 = C3 + 256, C5 = C4 + 256, C6 = C5 + 24, C7 = C6 + 16;
  const int s = (t >= C1) + (t >= C2) + (t >= C3) + (t >= C4) + (t >= C5) + (t >= C6) + (t >= C7);
  const int base = s == 0 ? 0 : s == 1 ? C1 : s == 2 ? C2 : s == 3 ? C3 : s == 4 ? C4 : s == 5 ? C5 : s == 6 ? C6 : C7;
  const int i = t - base;
  K = s == 2 ? DFF : s == 5 ? 256 : s == 6 ? 128 : s == 7 ? 64 : D;
  N = s == 0 ? DIN : s == 1 ? DFF : s == 5 ? 384 : s == 6 ? 512 : s == 7 ? 64 : D;
  const int ktiles_log2 = s == 2 ? 6 : s == 5 ? 2 : s == 6 ? 1 : s == 7 ? 0 : 4;
  tk = i & ((1 << ktiles_log2) - 1);
  tn = s == 7 ? 0 : (i >> ktiles_log2);
  const float* s0 = p.in[IWIN] + (size_t)l * D * DIN; const float* s1 = p.in[IWFF1] + (size_t)l * D * DFF; const float* s2 = p.in[IWFF2] + (size_t)l * D * DFF;
  const float* s3 = p.in[IWOUT] + (size_t)l * D * D; const float* s4 = p.in[IWBR] + (size_t)l * D * D; const float* s5 = p.in[IWQB] + (size_t)l * 256 * 384;
  const float* s6 = p.in[IWKVB] + (size_t)l * 128 * 512; const float* s7 = p.in[IPOOLW] + (size_t)(l * 4 + i) * 4096;
  src = s == 0 ? s0 : s == 1 ? s1 : s == 2 ? s2 : s == 3 ? s3 : s == 4 ? s4 : s == 5 ? s5 : s == 6 ? s6 : s7;
  const size_t off = s == 0 ? WS_WIN : s == 1 ? WS_WFF1 : s == 2 ? WS_WFF2 : s == 3 ? WS_WO : s == 4 ? WS_WBR : s == 5 ? WS_WQB : s == 6 ? WS_WKVB : (WS_WPOOL + (size_t)i * 8192);
  dst = (u16*)(p.ws + off);
}
#define CONV_LOAD(R, S_, N_, TK_, TN_) { const int n_ = (TN_) * 64 + nn; const float* s_ = (S_) + (size_t)((TK_) * 64 + kk) * (N_) + min(n_, (N_) - 1); const size_t st_ = (size_t)4 * (N_); \
  R##0 = s_[0]; R##1 = s_[st_]; R##2 = s_[2 * st_]; R##3 = s_[3 * st_]; R##4 = s_[4 * st_]; R##5 = s_[5 * st_]; R##6 = s_[6 * st_]; R##7 = s_[7 * st_]; \
  R##8 = s_[8 * st_]; R##9 = s_[9 * st_]; R##10 = s_[10 * st_]; R##11 = s_[11 * st_]; R##12 = s_[12 * st_]; R##13 = s_[13 * st_]; R##14 = s_[14 * st_]; R##15 = s_[15 * st_]; }
DI void phase_conv(const Params& p, int l, unsigned char* smem) {
  float* sm = (float*)smem;
  constexpr int NT = 16 * 108 + 16 * 64 + 64 * 16 + 256 + 256 + 24 + 16 + 4;
  const int tid = otid();
  const int nn = tid & 63, kk = tid >> 6;
  const int G = gridDim.x;
  if ((int)blockIdx.x < NT) {
    float c0, c1, c2, c3, c4, c5, c6, c7, c8, c9, c10, c11, c12, c13, c14, c15;
    float n0, n1, n2, n3, n4, n5, n6, n7, n8, n9, n10, n11, n12, n13, n14, n15;
    const float* csrc; u16* cdst; int cK, cN, ctk, ctn;
    conv_desc(p, l, blockIdx.x, csrc, cdst, cK, cN, ctk, ctn);
    CONV_LOAD(c, csrc, cN, ctk, ctn)
    for (int v = blockIdx.x; v < NT; v += G) {
      const float* nsrc; u16* ndst; int nK, nN, ntk, ntn;
      conv_desc(p, l, min(v + G, NT - 1), nsrc, ndst, nK, nN, ntk, ntn);
      CONV_LOAD(n, nsrc, nN, ntk, ntn)
      const bool inb = ctn * 64 + nn < cN;
      float* s = sm + kk * 65 + nn;
      s[0] = inb ? c0 : 0.f; s[4 * 65] = inb ? c1 : 0.f; s[8 * 65] = inb ? c2 : 0.f; s[12 * 65] = inb ? c3 : 0.f;
      s[16 * 65] = inb ? c4 : 0.f; s[20 * 65] = inb ? c5 : 0.f; s[24 * 65] = inb ? c6 : 0.f; s[28 * 65] = inb ? c7 : 0.f;
      s[32 * 65] = inb ? c8 : 0.f; s[36 * 65] = inb ? c9 : 0.f; s[40 * 65] = inb ? c10 : 0.f; s[44 * 65] = inb ? c11 : 0.f;
      s[48 * 65] = inb ? c12 : 0.f; s[52 * 65] = inb ? c13 : 0.f; s[56 * 65] = inb ? c14 : 0.f; s[60 * 65] = inb ? c15 : 0.f;
      __syncthreads();
      const int on = tid >> 2, kq = (tid & 3) * 16;
      unsigned w[8];
#pragma unroll
      for (int j = 0; j < 8; j++) w[j] = pack2(sm[(kq + 2 * j) * 65 + on], sm[(kq + 2 * j + 1) * 65 + on]);
      uint4* d = (uint4*)(cdst + (size_t)(ctn * 64 + on) * cK + ctk * 64 + kq);
      d[0] = make_uint4(w[0], w[1], w[2], w[3]);
      d[1] = make_uint4(w[4], w[5], w[6], w[7]);
      __syncthreads();
      csrc = nsrc; cdst = ndst; cK = nK; cN = nN; ctk = ntk; ctn = ntn;
      c0 = n0; c1 = n1; c2 = n2; c3 = n3; c4 = n4; c5 = n5; c6 = n6; c7 = n7; c8 = n8; c9 = n9; c10 = n10; c11 = n11; c12 = n12; c13 = n13; c14 = n14; c15 = n15;
    }
  }
  if (l == 0) for (int v = blockIdx.x; v < 192; v += G) mod_task(p, v, sm);
}

DI void phase_norm(const Params& p, int l, int half, int which, int b0 = 0, int nb = 0) {
  const int lane = otid() & 63, wave = otid() >> 6;
  const float* mod = (const float*)(p.ws + WS_MOD);
  const float* gain = p.in[which ? INORM2 : INORM1] + l * D;
  u16* H = (u16*)(p.ws + WS_H);
  if (nb == 0) nb = gridDim.x;
  if ((int)blockIdx.x < b0 || (int)blockIdx.x >= b0 + nb) return;
  auto src_of = [&](int r) -> const float* {
    const int bb = r / TB, t = r - bb * TB, b = half * 2 + bb;
    if (t < LAT) return ((which == 0 && l == 0) ? p.in[IX] : p.out) + ((size_t)b * LAT + t) * D;
    return ((which == 0 && l == 0) ? p.in[ICTX] : (const float*)(p.ws + WS_XC)) + ((size_t)b * CL + (t - LAT)) * D;
  };
  const int step = nb * 4;
  int r = ((int)blockIdx.x - b0) * 4 + wave;
  if (r >= RH) return;
  float4 n0, n1, n2, n3;
  { const float* s_ = src_of(r) + lane * 4; n0 = *(const float4*)(s_); n1 = *(const float4*)(s_ + 256); n2 = *(const float4*)(s_ + 512); n3 = *(const float4*)(s_ + 768); }
  for (; r < RH; r += step) {
    const int bb = r / TB, t = r - bb * TB, b = half * 2 + bb;
    float4 xv[4] = {n0, n1, n2, n3};
    { const float* s_ = src_of(r + step < RH ? r + step : r) + lane * 4; n0 = *(const float4*)(s_); n1 = *(const float4*)(s_ + 256); n2 = *(const float4*)(s_ + 512); n3 = *(const float4*)(s_ + 768); }
    if (t >= LAT && l == 1 && which == 1) continue;
    const float* mrow = mod + (size_t)(l * 5 + (t < LAT ? b : 4)) * 6144;
    const float* sh = mrow + (which ? 3 * D : 0);
    const float* sc = mrow + (which ? 4 * D : D);
    float ssq = 0;
#pragma unroll
    for (int i = 0; i < 4; i++) ssq += xv[i].x * xv[i].x + xv[i].y * xv[i].y + xv[i].z * xv[i].z + xv[i].w * xv[i].w;
    float4 gv[4], s1v[4], s0v[4];
#pragma unroll
    for (int i = 0; i < 4; i++) { const int c = i * 256 + lane * 4; gv[i] = *(const float4*)(gain + c); s1v[i] = *(const float4*)(sc + c); s0v[i] = *(const float4*)(sh + c); }
    asm volatile("" ::: "memory");
    ssq = wave_sum(ssq);
    const float rinv = rsqrtf(ssq * (1.f / D) + EPS);
#pragma unroll
    for (int i = 0; i < 4; i++) {
      const int c = i * 256 + lane * 4;
      const float4 g = gv[i], s1 = s1v[i], s0 = s0v[i];
      const float y0 = xv[i].x * rinv * g.x * (1.f + s1.x) + s0.x;
      const float y1 = xv[i].y * rinv * g.y * (1.f + s1.y) + s0.y;
      const float y2 = xv[i].z * rinv * g.z * (1.f + s1.z) + s0.z;
      const float y3 = xv[i].w * rinv * g.w * (1.f + s1.w) + s0.w;
      *(uint2*)(H + (size_t)r * D + c) = make_uint2(pack2(y0, y1), pack2(y2, y3));
    }
  }
}

constexpr int LDT = 72;
#define GK_LOAD(P, a0, a1, a2, a3, b0, b1, b2, b3) \
  a0 = *(const uint4*)(ap + (P)); a1 = *(const uint4*)(ap + sa32 + (P)); a2 = *(const uint4*)(ap + 2 * sa32 + (P)); a3 = *(const uint4*)(ap + 3 * sa32 + (P)); \
  b0 = *(const uint4*)(bp + (P)); b1 = *(const uint4*)(bp + sb32 + (P)); b2 = *(const uint4*)(bp + 2 * sb32 + (P)); b3 = *(const uint4*)(bp + 3 * sb32 + (P));
#define GK_STORE(a0, a1, a2, a3, b0, b1, b2, b3) \
  *(uint4*)(wa) = a0; *(uint4*)(wa + 32 * LDT) = a1; *(uint4*)(wa + 64 * LDT) = a2; *(uint4*)(wa + 96 * LDT) = a3; \
  *(uint4*)(wb) = b0; *(uint4*)(wb + 32 * LDT) = b1; *(uint4*)(wb + 64 * LDT) = b2; *(uint4*)(wb + 96 * LDT) = b3;
#define GK_COMPUTE \
  _Pragma("unroll") for (int ks = 0; ks < 2; ks++) { \
    const bf16x8 a0 = ldfrag(fa + ks * 32), a1 = ldfrag(fa + 16 * LDT + ks * 32), a2 = ldfrag(fa + 32 * LDT + ks * 32), a3 = ldfrag(fa + 48 * LDT + ks * 32); \
    const bf16x8 b0 = ldfrag(fb + ks * 32), b1 = ldfrag(fb + 16 * LDT + ks * 32), b2 = ldfrag(fb + 32 * LDT + ks * 32), b3 = ldfrag(fb + 48 * LDT + ks * 32); \
    acc[0][0] = MFMA(b0, a0, acc[0][0]); acc[0][1] = MFMA(b1, a0, acc[0][1]); acc[0][2] = MFMA(b2, a0, acc[0][2]); acc[0][3] = MFMA(b3, a0, acc[0][3]); \
    acc[1][0] = MFMA(b0, a1, acc[1][0]); acc[1][1] = MFMA(b1, a1, acc[1][1]); acc[1][2] = MFMA(b2, a1, acc[1][2]); acc[1][3] = MFMA(b3, a1, acc[1][3]); \
    acc[2][0] = MFMA(b0, a2, acc[2][0]); acc[2][1] = MFMA(b1, a2, acc[2][1]); acc[2][2] = MFMA(b2, a2, acc[2][2]); acc[2][3] = MFMA(b3, a2, acc[2][3]); \
    acc[3][0] = MFMA(b0, a3, acc[3][0]); acc[3][1] = MFMA(b1, a3, acc[3][1]); acc[3][2] = MFMA(b2, a3, acc[3][2]); acc[3][3] = MFMA(b3, a3, acc[3][3]); \
  }
constexpr int GT = 128 * LDT;
#define GK_STORE2(O, a0, a1, a2, a3, b0, b1, b2, b3) \
  *(uint4*)(wa + (O)) = a0; *(uint4*)(wa + (O) + 32 * LDT) = a1; *(uint4*)(wa + (O) + 64 * LDT) = a2; *(uint4*)(wa + (O) + 96 * LDT) = a3; \
  *(uint4*)(wb + (O)) = b0; *(uint4*)(wb + (O) + 32 * LDT) = b1; *(uint4*)(wb + (O) + 64 * LDT) = b2; *(uint4*)(wb + (O) + 96 * LDT) = b3;
#define GK_COMPUTE2(O) \
  _Pragma("unroll") for (int ks = 0; ks < 2; ks++) { \
    const bf16x8 a0 = ldfrag(fa + (O) + ks * 32), a1 = ldfrag(fa + (O) + 16 * LDT + ks * 32), a2 = ldfrag(fa + (O) + 32 * LDT + ks * 32), a3 = ldfrag(fa + (O) + 48 * LDT + ks * 32); \
    const bf16x8 b0 = ldfrag(fb + (O) + ks * 32), b1 = ldfrag(fb + (O) + 16 * LDT + ks * 32), b2 = ldfrag(fb + (O) + 32 * LDT + ks * 32), b3 = ldfrag(fb + (O) + 48 * LDT + ks * 32); \
    acc[0][0] = MFMA(b0, a0, acc[0][0]); acc[0][1] = MFMA(b1, a0, acc[0][1]); acc[0][2] = MFMA(b2, a0, acc[0][2]); acc[0][3] = MFMA(b3, a0, acc[0][3]); \
    acc[1][0] = MFMA(b0, a1, acc[1][0]); acc[1][1] = MFMA(b1, a1, acc[1][1]); acc[1][2] = MFMA(b2, a1, acc[1][2]); acc[1][3] = MFMA(b3, a1, acc[1][3]); \
    acc[2][0] = MFMA(b0, a2, acc[2][0]); acc[2][1] = MFMA(b1, a2, acc[2][1]); acc[2][2] = MFMA(b2, a2, acc[2][2]); acc[2][3] = MFMA(b3, a2, acc[2][3]); \
    acc[3][0] = MFMA(b0, a3, acc[3][0]); acc[3][1] = MFMA(b1, a3, acc[3][1]); acc[3][2] = MFMA(b2, a3, acc[3][2]); acc[3][3] = MFMA(b3, a3, acc[3][3]); \
  }
template <bool DEEP>
DI void gemm_kloop(f32x4 (&acc)[4][4], const u16* __restrict__ A, int lda, const u16* __restrict__ B, int ldb, int K, u16* sA, u16* sB) {
  const int tid = otid(), lane = tid & 63, wave = tid >> 6;
  const int wm = wave >> 1, wn = wave & 1, l15 = lane & 15, quad = lane >> 4;
  const int crow = tid >> 3, ckc = (tid & 7) * 8;
  const u16* ap = A + (size_t)crow * lda + ckc;
  const u16* bp = B + (size_t)crow * ldb + ckc;
  const size_t sa32 = (size_t)32 * lda, sb32 = (size_t)32 * ldb;
  u16* wa = sA + crow * LDT + ckc;
  u16* wb = sB + crow * LDT + ckc;
  const u16* fa = sA + (wm * 64 + l15) * LDT + quad * 8;
  const u16* fb = sB + (wn * 64 + l15) * LDT + quad * 8;
  uint4 ra0, ra1, ra2, ra3, rb0, rb1, rb2, rb3;
  GK_LOAD(0, ra0, ra1, ra2, ra3, rb0, rb1, rb2, rb3)
  __syncthreads();
  GK_STORE2(0, ra0, ra1, ra2, ra3, rb0, rb1, rb2, rb3)
  if (DEEP) {
    uint4 sa0, sa1, sa2, sa3, sb0, sb1, sb2, sb3;
    GK_LOAD(64, ra0, ra1, ra2, ra3, rb0, rb1, rb2, rb3)
    { const int k2 = min(128, K - 64); GK_LOAD(k2, sa0, sa1, sa2, sa3, sb0, sb1, sb2, sb3) }
    for (int k0 = 0; k0 < K; k0 += 128) {
      __syncthreads();
      GK_COMPUTE2(0)
      GK_STORE2(2 * GT, ra0, ra1, ra2, ra3, rb0, rb1, rb2, rb3)
      { const int kn = min(k0 + 192, K - 64); GK_LOAD(kn, ra0, ra1, ra2, ra3, rb0, rb1, rb2, rb3) }
      __syncthreads();
      GK_COMPUTE2(2 * GT)
      GK_STORE2(0, sa0, sa1, sa2, sa3, sb0, sb1, sb2, sb3)
      { const int kn = min(k0 + 256, K - 64); GK_LOAD(kn, sa0, sa1, sa2, sa3, sb0, sb1, sb2, sb3) }
    }
  } else {
    for (int k0 = 0; k0 < K; k0 += 128) {
      __syncthreads();
      GK_LOAD(k0 + 64, ra0, ra1, ra2, ra3, rb0, rb1, rb2, rb3)
      GK_COMPUTE2(0)
      GK_STORE2(2 * GT, ra0, ra1, ra2, ra3, rb0, rb1, rb2, rb3)
      __syncthreads();
      if (k0 + 128 < K) { GK_LOAD(k0 + 128, ra0, ra1, ra2, ra3, rb0, rb1, rb2, rb3) }
      GK_COMPUTE2(2 * GT)
      if (k0 + 128 < K) { GK_STORE2(0, ra0, ra1, ra2, ra3, rb0, rb1, rb2, rb3) }
    }
  }
}

DI bool tile_map(int v, int TM, int TN, int& tm, int& tn) {
  const int T = TM * TN, per = (T + 7) >> 3;
  const int g = (v & 7) * per + (v >> 3);
  if (g >= T) return false;
  const int group = g / (8 * TN), fm = group * 8;
  const int gsz = min(8, TM - fm), r = g - group * 8 * TN;
  tm = fm + r % gsz; tn = r / gsz;
  return true;
}
DI int tile_count(int TM, int TN) { return ((TM * TN + 7) >> 3) * 8; }
DI bool is_ctx_tile(int tm) { return ((tm * 128) % TB) >= LAT; }

#define ZERO_ACC(acc) _Pragma("unroll") for (int _a = 0; _a < 4; _a++) _Pragma("unroll") for (int _b = 0; _b < 4; _b++) acc[_a][_b] = f32x4{0.f, 0.f, 0.f, 0.f};

#define EPI_COORDS \
  const int lane_ = otid() & 63, wave_ = otid() >> 6; \
  const int wm_ = wave_ >> 1, wn_ = wave_ & 1, l15_ = lane_ & 15, quad_ = lane_ >> 4;

DI void phase_gemm_in(const Params& p, int l, u16* sm) {
  const u16* H = (const u16*)(p.ws + WS_H); const u16* W = (const u16*)(p.ws + WS_WIN); u16* U = (u16*)(p.ws + WS_U);
  constexpr int TM = RH / 128, TN = NU / 128;
  constexpr int NLAT = 64 * TN, NCTX = 4 * 12;
  const int nv = (l == 1) ? (NLAT + NCTX) : tile_count(TM, TN);
  EPI_COORDS
  for (int v = blockIdx.x; v < nv; v += gridDim.x) {
    int tm, tn;
    if (l == 1) {
      if (v < NLAT) { if (!tile_map(v, 64, TN, tm, tn)) continue; tm += 2 * (tm >> 5); }
      else { const int i = v - NLAT; const int tc = i / 12; tn = i - tc * 12; tm = 34 * (tc >> 1) + 32 + (tc & 1); }
    } else if (!tile_map(v, TM, TN, tm, tn)) continue;
    f32x4 acc[4][4]; ZERO_ACC(acc)
    gemm_kloop<true>(acc, H + (size_t)tm * 128 * D, D, W + (size_t)tn * 128 * D, D, D, sm, sm + 128 * LDT);
#pragma unroll
    for (int mt = 0; mt < 4; mt++)
#pragma unroll
      for (int nt = 0; nt < 4; nt++) {
        const int row = tm * 128 + wm_ * 64 + mt * 16 + l15_, col = tn * 128 + wn_ * 64 + nt * 16 + quad_ * 4;
        f32x4 v = acc[mt][nt];
        if (tn >= U_GHG / 128 && col >= U_GHG) {
          v[0] = sigmoidf_(v[0]); v[1] = sigmoidf_(v[1]); v[2] = sigmoidf_(v[2]); v[3] = sigmoidf_(v[3]);
        }
        *(uint2*)(U + (size_t)row * NU + col) = make_uint2(pack2(v[0], v[1]), pack2(v[2], v[3]));
      }
  }
}

DI void phase_merge(const Params& p, int l, u16* sm) {
  const u16* Y = (const u16*)(p.ws + WS_Y); const u16* W = (const u16*)(p.ws + WS_WBR); const u16* U = (const u16*)(p.ws + WS_U);
  u16* Z = (u16*)(p.ws + WS_H);
  constexpr int TM = RH / 128, TN = D / 128;
  EPI_COORDS
  const int TMe = (l == 1) ? 64 : TM;
  for (int v = blockIdx.x; v < tile_count(TMe, TN); v += gridDim.x) {
    int tm, tn; if (!tile_map(v, TMe, TN, tm, tn)) continue;
    if (l == 1) tm += 2 * (tm >> 5);
    f32x4 tot[4][4]; ZERO_ACC(tot)
    for (int seg = 0; seg < 4; seg++) {
      f32x4 acc[4][4]; ZERO_ACC(acc)
      gemm_kloop<false>(acc, Y + (size_t)tm * 128 * D + seg * 256, D, W + (size_t)tn * 128 * D + seg * 256, D, 256, sm, sm + 128 * LDT);
#pragma unroll
      for (int mt = 0; mt < 4; mt++)
#pragma unroll
        for (int nt = 0; nt < 4; nt++) {
          const int row = tm * 128 + wm_ * 64 + mt * 16 + l15_, col = tn * 128 + wn_ * 64 + nt * 16 + quad_ * 4;
          float g[4]; unpack4(*(const uint2*)(U + (size_t)row * NU + U_GATE + seg * 1024 + col), g);
#pragma unroll
          for (int j = 0; j < 4; j++) tot[mt][nt][j] += g[j] * acc[mt][nt][j];
        }
    }
#pragma unroll
    for (int mt = 0; mt < 4; mt++)
#pragma unroll
      for (int nt = 0; nt < 4; nt++) {
        const int row = tm * 128 + wm_ * 64 + mt * 16 + l15_, col = tn * 128 + wn_ * 64 + nt * 16 + quad_ * 4;
        *(uint2*)(Z + (size_t)row * D + col) = make_uint2(pack2(tot[mt][nt][0], tot[mt][nt][1]), pack2(tot[mt][nt][2], tot[mt][nt][3]));
      }
  }
}

DI void phase_resid(const Params& p, int l, int half, int which, u16* sm) {
  const u16* A = (const u16*)(p.ws + (which ? WS_U : WS_H));
  const u16* W = (const u16*)(p.ws + (which ? WS_WFF2 : WS_WO));
  const int K = which ? DFF : D;
  const float* mod = (const float*)(p.ws + WS_MOD);
  float* xc = (float*)(p.ws + WS_XC);
  constexpr int TM = RH / 128, TN = D / 128;
  EPI_COORDS
  const int TMe = (l == 1) ? 64 : TM;
  for (int v = blockIdx.x; v < tile_count(TMe, TN); v += gridDim.x) {
    int tm, tn; if (!tile_map(v, TMe, TN, tm, tn)) continue;
    if (l == 1) tm += 2 * (tm >> 5);
    f32x4 acc[4][4]; ZERO_ACC(acc)
    gemm_kloop<true>(acc, A + (size_t)tm * 128 * K, K, W + (size_t)tn * 128 * K, K, K, sm, sm + 128 * LDT);
#pragma unroll
    for (int mt = 0; mt < 4; mt++) {
      const int row = tm * 128 + wm_ * 64 + mt * 16 + l15_;
      const int bb = row / TB, t = row - bb * TB, b = half * 2 + bb;
      const bool lat = t < LAT;
      const float* gate = mod + (size_t)(l * 5 + (lat ? b : 4)) * 6144 + (which ? 5 * D : 2 * D);
      const float* src; float* dst;
      if (lat) {
        dst = p.out + ((size_t)b * LAT + t) * D;
        src = (which == 0 && l == 0) ? p.in[IX] + ((size_t)b * LAT + t) * D : dst;
      } else {
        dst = xc + ((size_t)b * CL + (t - LAT)) * D;
        src = (which == 0 && l == 0) ? p.in[ICTX] + ((size_t)b * CL + (t - LAT)) * D : dst;
      }
#pragma unroll
      for (int nt = 0; nt < 4; nt++) {
        const int col = tn * 128 + wn_ * 64 + nt * 16 + quad_ * 4;
        const float4 g = *(const float4*)(gate + col);
        float4 x = *(const float4*)(src + col);
        x.x += g.x * acc[mt][nt][0]; x.y += g.y * acc[mt][nt][1]; x.z += g.z * acc[mt][nt][2]; x.w += g.w * acc[mt][nt][3];
        *(float4*)(dst + col) = x;
      }
    }
  }
}

DI void phase_ff1(const Params& p, int l, u16* sm) {
  const u16* H = (const u16*)(p.ws + WS_H); const u16* W = (const u16*)(p.ws + WS_WFF1); u16* F = (u16*)(p.ws + WS_U);
  constexpr int TM = RH / 128, TN = DFF / 128;
  EPI_COORDS
  const int TMe = (l == 1) ? 64 : TM;
  for (int v = blockIdx.x; v < tile_count(TMe, TN); v += gridDim.x) {
    int tm, tn; if (!tile_map(v, TMe, TN, tm, tn)) continue;
    if (l == 1) tm += 2 * (tm >> 5);
    f32x4 acc[4][4]; ZERO_ACC(acc)
    gemm_kloop<true>(acc, H + (size_t)tm * 128 * D, D, W + (size_t)tn * 128 * D, D, D, sm, sm + 128 * LDT);
#pragma unroll
    for (int mt = 0; mt < 4; mt++)
#pragma unroll
      for (int nt = 0; nt < 4; nt++) {
        const int row = tm * 128 + wm_ * 64 + mt * 16 + l15_, col = tn * 128 + wn_ * 64 + nt * 16 + quad_ * 4;
        float r[4];
#pragma unroll
        for (int j = 0; j < 4; j++) { const float x = fmaxf(acc[mt][nt][j], 0.f); r[j] = x * x; }
        *(uint2*)(F + (size_t)row * DFF + col) = make_uint2(pack2(r[0], r[1]), pack2(r[2], r[3]));
      }
  }
}

DI void head_norm_rope(f32x4 (&a)[6], const float* __restrict__ gain, bool rope, int t, int quad, float outscale) {
  float ssq = 0;
#pragma unroll
  for (int nt = 0; nt < 6; nt++)
#pragma unroll
    for (int j = 0; j < 4; j++) ssq += a[nt][j] * a[nt][j];
  ssq = quad_sum(ssq);
  const float rinv = rsqrtf(ssq * (1.f / 96.f) + EPS);
#pragma unroll
  for (int nt = 0; nt < 6; nt++) {
    const float4 g = *(const float4*)(gain + nt * 16 + quad * 4);
    a[nt][0] *= rinv * g.x; a[nt][1] *= rinv * g.y; a[nt][2] *= rinv * g.z; a[nt][3] *= rinv * g.w;
  }
#pragma unroll
  for (int ax = 0; ax < 2; ax++) {
    const float pos = (float)(ax == 0 ? (t >> 6) : (t & 63));
    const bool hi = (quad & 1) != 0, second = (quad & 2) != 0;
    const float c_lo[4] = {1.f, 0.31622776601683794f, 0.1f, 0.031622776601683794f};
    const float c_hi[4] = {0.01f, 0.0031622776601683794f, 0.001f, 0.00031622776601683794f};
#pragma unroll
    for (int j = 0; j < 4; j++) {
      const float mine = a[4 + ax][j];
      const float other = __shfl_xor(mine, 32);
      const float ang = pos * (hi ? c_hi[j] : c_lo[j]);
      const float cs = __cosf(ang), sn = __sinf(ang);
      const float r = second ? (mine * cs + other * sn) : (mine * cs - other * sn);
      if (rope) a[4 + ax][j] = r;
    }
  }
#pragma unroll
  for (int nt = 0; nt < 6; nt++)
#pragma unroll
    for (int j = 0; j < 4; j++) a[nt][j] *= outscale;
}

#define SCHED_FENCE
DI void prep_task(const Params& p, int l, int task) {
  const int lane = otid() & 63, l15 = lane & 15, quad = lane >> 4;
  const int h = task & 3;
  const int r0 = (task >> 2) * 64 + (otid() >> 6) * 16, row = r0 + l15;
  const int bb = r0 / TB, t0 = r0 - bb * TB, t = t0 + l15;
  const bool lat = t0 < LAT;
  const u16* U = (const u16*)(p.ws + WS_U);
  const u16* urow = U + (size_t)row * NU;
  const u16* Wq = (const u16*)(p.ws + WS_WQB);
  const u16* Wkv = (const u16*)(p.ws + WS_WKVB);
  u16* Qm = (u16*)(p.ws + WS_QM); u16* Km = (u16*)(p.ws + WS_KM); u16* VTm = (u16*)(p.ws + WS_VTM);
  u16* Qn = (u16*)(p.ws + WS_QN); u16* Kn = (u16*)(p.ws + WS_KN); u16* VTn = (u16*)(p.ws + WS_VTN);

  uint4 rq[8], rk[4]; uint2 rr[2];
#pragma unroll
  for (int ks = 0; ks < 8; ks++) rq[ks] = *(const uint4*)(urow + U_QA + ks * 32 + quad * 8);
#pragma unroll
  for (int ks = 0; ks < 4; ks++) rk[ks] = *(const uint4*)(urow + U_KVA + ks * 32 + quad * 8);
#pragma unroll
  for (int tt = 0; tt < 2; tt++) rr[tt] = *(const uint2*)(urow + U_KVA + 128 + tt * 16 + quad * 4);
  bf16x8 wf[16];
#pragma unroll
  for (int ks = 0; ks < 8; ks++) wf[ks] = ldfrag(Wq + (size_t)(h * 96 + l15) * 256 + quad * 8 + ks * 32);
  SCHED_FENCE;

  bf16x8 afq[8];
  {
    float ssq = 0;
#pragma unroll
    for (int ks = 0; ks < 8; ks++) {
      float v[8]; unpack8(rq[ks], v);
#pragma unroll
      for (int j = 0; j < 8; j++) ssq += v[j] * v[j];
    }
    ssq = quad_sum(ssq);
    const float rinv = rsqrtf(ssq * (1.f / 256.f) + EPS);
    const float* g = p.in[IQNORM] + l * 256;
#pragma unroll
    for (int ks = 0; ks < 8; ks++) {
      float v[8]; unpack8(rq[ks], v);
      const float4 g0 = *(const float4*)(g + ks * 32 + quad * 8), g1 = *(const float4*)(g + ks * 32 + quad * 8 + 4);
      float o[8] = {v[0] * rinv * g0.x, v[1] * rinv * g0.y, v[2] * rinv * g0.z, v[3] * rinv * g0.w,
                    v[4] * rinv * g1.x, v[5] * rinv * g1.y, v[6] * rinv * g1.z, v[7] * rinv * g1.w};
      afq[ks] = as_frag(pack8u(o));
    }
  }
  f32x4 qa[6];
#pragma unroll
  for (int nt = 0; nt < 6; nt++) {
    const int cur = (nt & 1) * 8, nxt = 8 - cur;
    if (nt < 5) {
#pragma unroll
      for (int ks = 0; ks < 8; ks++) wf[nxt + ks] = ldfrag(Wq + (size_t)(h * 96 + (nt + 1) * 16 + l15) * 256 + quad * 8 + ks * 32);
    }
    SCHED_FENCE;
    qa[nt] = f32x4{0.f, 0.f, 0.f, 0.f};
#pragma unroll
    for (int ks = 0; ks < 8; ks++) qa[nt] = MFMA(wf[cur + ks], afq[ks], qa[nt]);
    SCHED_FENCE;
  }
#pragma unroll
  for (int nt = 0; nt < 4; nt++)
#pragma unroll
    for (int ks = 0; ks < 4; ks++) wf[nt * 4 + ks] = ldfrag(Wkv + (size_t)(h * 128 + nt * 16 + l15) * 128 + quad * 8 + ks * 32);
  SCHED_FENCE;
  bf16x8 afk[4];
  {
    float ssq = 0;
#pragma unroll
    for (int ks = 0; ks < 4; ks++) {
      float v[8]; unpack8(rk[ks], v);
#pragma unroll
      for (int j = 0; j < 8; j++) ssq += v[j] * v[j];
    }
    ssq = quad_sum(ssq);
    const float rinv = rsqrtf(ssq * (1.f / 128.f) + EPS);
    const float* g = p.in[IKVNORM] + l * 128;
#pragma unroll
    for (int ks = 0; ks < 4; ks++) {
      float v[8]; unpack8(rk[ks], v);
      const float4 g0 = *(const float4*)(g + ks * 32 + quad * 8), g1 = *(const float4*)(g + ks * 32 + quad * 8 + 4);
      float o[8] = {v[0] * rinv * g0.x, v[1] * rinv * g0.y, v[2] * rinv * g0.z, v[3] * rinv * g0.w,
                    v[4] * rinv * g1.x, v[5] * rinv * g1.y, v[6] * rinv * g1.z, v[7] * rinv * g1.w};
      afk[ks] = as_frag(pack8u(o));
    }
  }
  f32x4 ka[6];
#pragma unroll
  for (int nt = 0; nt < 4; nt++) {
    ka[nt] = f32x4{0.f, 0.f, 0.f, 0.f};
#pragma unroll
    for (int ks = 0; ks < 4; ks++) ka[nt] = MFMA(wf[nt * 4 + ks], afk[ks], ka[nt]);
  }
  SCHED_FENCE;
#pragma unroll
  for (int nt = 0; nt < 4; nt++)
#pragma unroll
    for (int ks = 0; ks < 4; ks++) wf[nt * 4 + ks] = ldfrag(Wkv + (size_t)(h * 128 + 64 + nt * 16 + l15) * 128 + quad * 8 + ks * 32);
  uint4 nq[2], nk[2]; u16 ev[16];
#pragma unroll
  for (int i = 0; i < 2; i++) { nq[i] = *(const uint4*)(urow + U_QNA + h * 64 + quad * 16 + i * 8); nk[i] = *(const uint4*)(urow + U_KNA + h * 64 + quad * 16 + i * 8); }
#pragma unroll
  for (int nt = 0; nt < 4; nt++)
#pragma unroll
    for (int j = 0; j < 4; j++) ev[nt * 4 + j] = U[(size_t)(r0 + quad * 4 + j) * NU + U_VNA + h * 64 + nt * 16 + l15];
  SCHED_FENCE;
  head_norm_rope(qa, p.in[IGQ] + l * 96, lat, t, quad, 0.14724444602590306f  );
#pragma unroll
  for (int nt = 0; nt < 6; nt++)
    *(uint2*)(Qm + (size_t)row * 512 + h * 128 + nt * 16 + quad * 4) = make_uint2(pack2(qa[nt][0], qa[nt][1]), pack2(qa[nt][2], qa[nt][3]));
#pragma unroll
  for (int tt = 0; tt < 2; tt++) {
    float kr[4]; unpack4(rr[tt], kr);
    ka[4 + tt] = f32x4{kr[0], kr[1], kr[2], kr[3]};
  }
  head_norm_rope(ka, p.in[IGK] + l * 96, lat, t, quad, 1.f);
#pragma unroll
  for (int nt = 0; nt < 6; nt++)
    *(uint2*)(Km + (size_t)row * 512 + h * 128 + nt * 16 + quad * 4) = make_uint2(pack2(ka[nt][0], ka[nt][1]), pack2(ka[nt][2], ka[nt][3]));
#pragma unroll
  for (int nt = 0; nt < 4; nt++) {
    f32x4 va = f32x4{0.f, 0.f, 0.f, 0.f};
#pragma unroll
    for (int ks = 0; ks < 4; ks++) va = MFMA(afk[ks], wf[nt * 4 + ks], va);
    *(uint2*)(VTm + ((size_t)(bb * 4 + h) * 64 + nt * 16 + l15) * TB + t0 + quad * 4) = make_uint2(pack2(va[0], va[1]), pack2(va[2], va[3]));
  }
#pragma unroll
  for (int qk = 0; qk < 2; qk++) {
    const float* g = p.in[qk ? INAGK : INAGQ] + l * 64 + quad * 16;
    float v[16];
    unpack8(qk ? nk[0] : nq[0], v); unpack8(qk ? nk[1] : nq[1], v + 8);
    float ssq = 0;
#pragma unroll
    for (int j = 0; j < 16; j++) ssq += v[j] * v[j];
    ssq = quad_sum(ssq);
    const float rinv = rsqrtf(ssq * (1.f / 64.f) + EPS) * (qk ? 1.f : 0.18033688011112042f  );
#pragma unroll
    for (int j = 0; j < 16; j++) v[j] *= rinv * g[j];
    u16* dst = (qk ? Kn : Qn) + (size_t)row * 256 + h * 64 + quad * 16;
    *(uint4*)dst = pack8u(v); *(uint4*)(dst + 8) = pack8u(v + 8);
  }
#pragma unroll
  for (int nt = 0; nt < 4; nt++)
    *(uint2*)(VTn + ((size_t)(bb * 4 + h) * 64 + nt * 16 + l15) * TB + t0 + quad * 4) =
        make_uint2((unsigned)ev[nt * 4] | ((unsigned)ev[nt * 4 + 1] << 16), (unsigned)ev[nt * 4 + 2] | ((unsigned)ev[nt * 4 + 3] << 16));
}

DI float lb_val(const Params& p, int l, int dir, int ch) {
  const float* a = p.in[IHGLB];
  const float a0 = a[(0 * 2 + dir) * 256 + ch], a1 = a[(1 * 2 + dir) * 256 + ch], a2 = a[(2 * 2 + dir) * 256 + ch];
  const float mx = fmaxf(a0, fmaxf(a1, a2));
  const float e0 = __expf(a0 - mx), e1 = __expf(a1 - mx), e2 = __expf(a2 - mx);
  const float inv = 1.f / (e0 + e1 + e2);
  const float v = (l == 0) ? e0 * inv : (e0 + e1) * inv;
  return fminf(fmaxf(v, 1e-6f), 1.f - 1e-6f);
}

DI void hg1_task(const Params& p, int l, int task, unsigned char* smem) {
  const int tid = otid(), d = tid & 63, seg = tid >> 6;
  const int seq = task / 68, s = task - seq * 68;
  const int bb = seq >> 3, h = (seq >> 1) & 3, dir = seq & 1;
  u16* KT = (u16*)smem; u16* IT = KT + 64 * LDT; float* tot = (float*)(IT + 64 * LDT);
  const u16* U = (const u16*)(p.ws + WS_U);
  const bool isctx = s < 4;
  const int cpos = (isctx ? s : s - 4) * 64;
  const float lb = lb_val(p, l, dir, h * 64 + d);
  float kk[16], bc[16]; u16 iv[16], zr[16]; float run = 0;
#pragma unroll
  for (int e = 0; e < 16; e++) {
    const int pos = cpos + seg * 16 + e;
    const int t = isctx ? (LAT + (dir ? 255 - pos : pos)) : (dir ? 4095 - pos : pos);
    const u16* ur = U + (size_t)(bb * TB + t) * NU;
    zr[e] = ur[U_ZF + dir * 256 + h * 64 + d];
    iv[e] = ur[U_I + h * 64 + d];
  }
  asm volatile("" ::: "memory");
#pragma unroll
  for (int e = 0; e < 16; e++) {
    const float z = bf2f(zr[e]);
    const float sg = __builtin_amdgcn_rcpf(1.f + __expf(z));
    kk[e] = (1.f - lb) * sg;
    run += __logf(1.f - kk[e]);
    bc[e] = run;
  }
  tot[seg * 64 + d] = run;
  __syncthreads();
  float pre = 0, bl = 0;
#pragma unroll
  for (int q = 0; q < 4; q++) { const float tv = tot[q * 64 + d]; if (q < seg) pre += tv; bl += tv; }
  {
    float o[16];
#pragma unroll
    for (int e = 0; e < 16; e++) o[e] = kk[e] * __expf(bl - (pre + bc[e]));
    *(uint4*)(KT + d * LDT + seg * 16) = pack8u(o); *(uint4*)(KT + d * LDT + seg * 16 + 8) = pack8u(o + 8);
    uint4 i0 = make_uint4(iv[0] | ((unsigned)iv[1] << 16), iv[2] | ((unsigned)iv[3] << 16), iv[4] | ((unsigned)iv[5] << 16), iv[6] | ((unsigned)iv[7] << 16));
    uint4 i1 = make_uint4(iv[8] | ((unsigned)iv[9] << 16), iv[10] | ((unsigned)iv[11] << 16), iv[12] | ((unsigned)iv[13] << 16), iv[14] | ((unsigned)iv[15] << 16));
    *(uint4*)(IT + d * LDT + seg * 16) = i0; *(uint4*)(IT + d * LDT + seg * 16 + 8) = i1;
  }
  if (seg == 0) ((float*)(p.ws + WS_DEC))[(size_t)(seq * 68 + s) * 64 + d] = __expf(bl);
  __syncthreads();
  {
    const int lane = tid & 63, w = seg, l15 = lane & 15, quad = lane >> 4;
    f32x4 acc[4];
#pragma unroll
    for (int nt = 0; nt < 4; nt++) acc[nt] = f32x4{0.f, 0.f, 0.f, 0.f};
#pragma unroll
    for (int ks = 0; ks < 2; ks++) {
      const bf16x8 a = ldfrag(KT + (w * 16 + l15) * LDT + ks * 32 + quad * 8);
#pragma unroll
      for (int nt = 0; nt < 4; nt++) acc[nt] = MFMA(a, ldfrag(IT + (nt * 16 + l15) * LDT + ks * 32 + quad * 8), acc[nt]);
    }
    float* S = (float*)(p.ws + WS_S) + (size_t)(seq * 68 + s) * 4096;
#pragma unroll
    for (int nt = 0; nt < 4; nt++)
#pragma unroll
      for (int j = 0; j < 4; j++) S[(w * 16 + quad * 4 + j) * 64 + nt * 16 + l15] = acc[nt][j];
  }
  __syncthreads();
}

DI void hg2_task(const Params& p, int task) {
  const int idx = task * 256 + otid();
  const int seq = idx >> 12, e = idx & 4095, d = e >> 6;
  float* S = (float*)(p.ws + WS_S) + (size_t)seq * 68 * 4096 + e;
  const float* dec = (const float*)(p.ws + WS_DEC) + (size_t)seq * 68 * 64 + d;
  float st = 0.f;
  for (int s0 = 0; s0 < 68; s0 += 17) {
    float tmp[17], dc[17];
#pragma unroll
    for (int j = 0; j < 17; j++) { tmp[j] = S[(size_t)(s0 + j) * 4096]; dc[j] = dec[(s0 + j) * 64]; }
#pragma unroll
    for (int j = 0; j < 17; j++) { S[(size_t)(s0 + j) * 4096] = st; st = dc[j] * st + tmp[j]; }
  }
}

DI void hg3_task(const Params& p, int l, int task, unsigned char* smem) {
  const int tid = otid(), d = tid & 63, seg = tid >> 6;
  const int lane = tid & 63, w = seg, l15 = lane & 15, quad = lane >> 4;
  int bb, h, c, base; bool isctx;
  if (task < 512) { bb = task >> 8; h = (task >> 6) & 3; c = task & 63; base = c * 64; isctx = false; }
  else { const int q = task - 512; bb = q >> 4; h = (q >> 2) & 3; c = q & 3; base = LAT + c * 64; isctx = true; }
  u16* QT = (u16*)smem; u16* KT = QT + 64 * LDT; u16* QE = KT + 64 * LDT; u16* IT = QE + 64 * LDT; u16* ST = IT + 64 * LDT;
  float* O = (float*)(ST + 64 * LDT); float* tot = O + 64 * 64;
  const u16* U = (const u16*)(p.ws + WS_U);
  for (int dir = 0; dir < 2; dir++) {
    const int s = isctx ? (dir ? 3 - c : c) : (dir ? 4 + 63 - c : 4 + c);
    const int seq = (bb * 4 + h) * 2 + dir;
    const float lb = lb_val(p, l, dir, h * 64 + d);
    float kk[16], bc[16], qv[16]; u16 iv[16], zr[16], qr[16]; float sv[16]; float run = 0;
#pragma unroll
    for (int e = 0; e < 16; e++) {
      const int i = seg * 16 + e;
      const int tl = dir ? 63 - i : i;
      const u16* ur = U + (size_t)(bb * TB + base + tl) * NU;
      zr[e] = ur[U_ZF + dir * 256 + h * 64 + d];
      qr[e] = ur[U_QHG + h * 64 + d];
      iv[e] = ur[U_I + h * 64 + d];
    }
    {
      const float* Sg = (const float*)(p.ws + WS_S) + (size_t)(seq * 68 + s) * 4096;
#pragma unroll
      for (int e = 0; e < 16; e++) sv[e] = Sg[(seg * 16 + e) * 64 + d];
    }
    asm volatile("" ::: "memory");
#pragma unroll
    for (int e = 0; e < 16; e++) {
      const float z = bf2f(zr[e]);
      qv[e] = bf2f(qr[e]) * 0.125f;
      const float sg = __builtin_amdgcn_rcpf(1.f + __expf(z));
      kk[e] = (1.f - lb) * sg;
      run += __logf(1.f - kk[e]);
      bc[e] = run;
    }
    tot[seg * 64 + d] = run;
    __syncthreads();
    float pre = 0;
#pragma unroll
    for (int q = 0; q < 4; q++) { const float tv = tot[q * 64 + d]; if (q < seg) pre += tv; }
    const float bm = tot[d] + tot[64 + d];
#pragma unroll
    for (int e = 0; e < 16; e++) {
      const int i = seg * 16 + e;
      const float b = pre + bc[e];
      QT[i * LDT + d] = f2bf(qv[e] * __expf(b - bm));
      KT[i * LDT + d] = f2bf(kk[e] * __expf(bm - b));
      QE[i * LDT + d] = f2bf(qv[e] * __expf(b));
    }
    {
      uint4 i0 = make_uint4(iv[0] | ((unsigned)iv[1] << 16), iv[2] | ((unsigned)iv[3] << 16), iv[4] | ((unsigned)iv[5] << 16), iv[6] | ((unsigned)iv[7] << 16));
      uint4 i1 = make_uint4(iv[8] | ((unsigned)iv[9] << 16), iv[10] | ((unsigned)iv[11] << 16), iv[12] | ((unsigned)iv[13] << 16), iv[14] | ((unsigned)iv[15] << 16));
      *(uint4*)(IT + d * LDT + seg * 16) = i0; *(uint4*)(IT + d * LDT + seg * 16 + 8) = i1;
      *(uint4*)(ST + d * LDT + seg * 16) = pack8u(sv); *(uint4*)(ST + d * LDT + seg * 16 + 8) = pack8u(sv + 8);
    }
    __syncthreads();
    f32x4 am[4];
#pragma unroll
    for (int nt = 0; nt < 4; nt++) am[nt] = f32x4{0.f, 0.f, 0.f, 0.f};
#pragma unroll
    for (int ks = 0; ks < 2; ks++) {
      const bf16x8 a = ldfrag(QT + (w * 16 + l15) * LDT + ks * 32 + quad * 8);
#pragma unroll
      for (int nt = 0; nt < 4; nt++) am[nt] = MFMA(a, ldfrag(KT + (nt * 16 + l15) * LDT + ks * 32 + quad * 8), am[nt]);
    }
    __syncthreads();
#pragma unroll
    for (int nt = 0; nt < 4; nt++)
#pragma unroll
      for (int j = 0; j < 4; j++) {
        const int tt = w * 16 + quad * 4 + j, ss = nt * 16 + l15;
        QT[tt * LDT + ss] = (ss <= tt) ? f2bf(am[nt][j]) : (u16)0;
      }
    __syncthreads();
    f32x4 o[4];
#pragma unroll
    for (int nt = 0; nt < 4; nt++) o[nt] = f32x4{0.f, 0.f, 0.f, 0.f};
#pragma unroll
    for (int ks = 0; ks < 2; ks++) {
      const bf16x8 a = ldfrag(QT + (w * 16 + l15) * LDT + ks * 32 + quad * 8);
      const bf16x8 a2 = ldfrag(QE + (w * 16 + l15) * LDT + ks * 32 + quad * 8);
#pragma unroll
      for (int nt = 0; nt < 4; nt++) {
        o[nt] = MFMA(a, ldfrag(IT + (nt * 16 + l15) * LDT + ks * 32 + quad * 8), o[nt]);
        o[nt] = MFMA(a2, ldfrag(ST + (nt * 16 + l15) * LDT + ks * 32 + quad * 8), o[nt]);
      }
    }
#pragma unroll
    for (int nt = 0; nt < 4; nt++)
#pragma unroll
      for (int j = 0; j < 4; j++) {
        const int i = w * 16 + quad * 4 + j;
        const int tl = dir ? 63 - i : i;
        if (dir == 0) O[tl * 64 + nt * 16 + l15] = o[nt][j]; else O[tl * 64 + nt * 16 + l15] += o[nt][j];
      }
    __syncthreads();
  }
  {
    const int tl = tid >> 2, vq = (tid & 3) * 16;
    const size_t row = (size_t)(bb * TB + base + tl);
    float ov[16]; float ssq = 0;
#pragma unroll
    for (int j = 0; j < 16; j++) { ov[j] = O[tl * 64 + vq + j]; ssq += ov[j] * ov[j]; }
    ssq += __shfl_xor(ssq, 1); ssq += __shfl_xor(ssq, 2);
    const float rinv = rsqrtf(ssq * (1.f / 64.f) + EPS);
    float g[16];
    unpack8(*(const uint4*)(U + row * NU + U_GHG + h * 64 + vq), g); unpack8(*(const uint4*)(U + row * NU + U_GHG + h * 64 + vq + 8), g + 8);
    const float* gn = p.in[IHGNORM] + l * 64 + vq;
#pragma unroll
    for (int j = 0; j < 16; j++) ov[j] = ov[j] * rinv * gn[j] * g[j];
    u16* dst = (u16*)(p.ws + WS_Y) + row * D + 768 + h * 64 + vq;
    *(uint4*)dst = pack8u(ov); *(uint4*)(dst + 8) = pack8u(ov + 8);
  }
  __syncthreads();
}

DI void pool_task(const Params& p, int l, int task, unsigned char* smem) {
  const int tid = otid(), lane = tid & 63, g = tid >> 6, l15 = lane & 15, quad = lane >> 4;
  int bb, tt, Ls, rowbase;
  if (task < 128) { bb = task >> 6; tt = task & 63; Ls = LAT; rowbase = bb * TB; }
  else { const int q = task - 128; bb = q >> 2; tt = q & 3; Ls = CL; rowbase = bb * TB + LAT; }
  constexpr int PS = 264;
  u16* PU = (u16*)smem;
  const u16* U = (const u16*)(p.ws + WS_U);
  const int t0 = tt * 64;
  for (int c = tid; c < 80 * 32; c += 256) {
    const int r = c >> 5, cc = (c & 31) * 8;
    const int pos = t0 - 8 + r;
    uint4 val = make_uint4(0, 0, 0, 0);
    if (pos >= 0 && pos < Ls) val = *(const uint4*)(U + (size_t)(rowbase + pos) * NU + U_POOL + cc);
    *(uint4*)(PU + r * PS + cc) = val;
  }
  __syncthreads();
  const int w = 2 << g, hw = w >> 1;
  const u16* Wt = (const u16*)(p.ws + WS_WPOOL) + g * 4096;
  f32x4 acc[4][4]; ZERO_ACC(acc)
#pragma unroll
  for (int mt = 0; mt < 4; mt++) {
    const int tloc = mt * 16 + l15, pos = t0 + tloc;
    const int lo = max(pos - hw, 0), hi = min(pos - hw + w, Ls);
    const float inv = 1.f / (float)(hi - lo);
#pragma unroll
    for (int ks = 0; ks < 2; ks++) {
      const int chb = g * 64 + ks * 32 + quad * 8;
      float sum[8] = {0, 0, 0, 0, 0, 0, 0, 0};
      for (int r = 0; r < w; r++) {
        float f[8]; unpack8(*(const uint4*)(PU + (tloc + 8 - hw + r) * PS + chb), f);
#pragma unroll
        for (int j = 0; j < 8; j++) sum[j] += f[j];
      }
      float self[8]; unpack8(*(const uint4*)(PU + (tloc + 8) * PS + chb), self);
#pragma unroll
      for (int j = 0; j < 8; j++) sum[j] = sum[j] * inv - self[j];
      const bf16x8 pf = as_frag(pack8u(sum));
#pragma unroll
      for (int nt = 0; nt < 4; nt++) acc[mt][nt] = MFMA(ldfrag(Wt + (nt * 16 + l15) * 64 + ks * 32 + quad * 8), pf, acc[mt][nt]);
    }
  }
  u16* Y = (u16*)(p.ws + WS_Y);
#pragma unroll
  for (int mt = 0; mt < 4; mt++)
#pragma unroll
    for (int nt = 0; nt < 4; nt++) {
      const int e0 = nt * 16 + quad * 4;
      const float4 sc = *(const float4*)(p.in[IPOOLS] + l * 256 + g * 64 + e0);
      const size_t row = (size_t)(rowbase + t0 + mt * 16 + l15);
      *(uint2*)(Y + row * D + g * 64 + e0) = make_uint2(pack2(acc[mt][nt][0] * sc.x, acc[mt][nt][1] * sc.y), pack2(acc[mt][nt][2] * sc.z, acc[mt][nt][3] * sc.w));
    }
  __syncthreads();
}

template <int NKS> struct KVStage { bf16x8 kf[2][NKS]; bf16x8 vf[4]; };
template <int NKS>
DI void kv_load(KVStage<NKS>& s, const u16* __restrict__ Kp, int ldk, const u16* __restrict__ VT, int kbase, int l15, int quad) {
#pragma unroll
  for (int kt = 0; kt < 2; kt++)
#pragma unroll
    for (int ks = 0; ks < NKS; ks++) s.kf[kt][ks] = ldfrag(Kp + (size_t)(kbase + kt * 16 + l15) * ldk + ks * 32 + quad * 8);
#pragma unroll
  for (int dt = 0; dt < 4; dt++) {
    const u16* vp = VT + (size_t)(dt * 16 + l15) * TB + kbase + quad * 4;
    const uint2 lo = *(const uint2*)vp, hi = *(const uint2*)(vp + 16);
    s.vf[dt] = as_frag(make_uint4(lo.x, lo.y, hi.x, hi.y));
  }
}

template <int DQK, int NQT, bool NA>
DI void attn_block(const u16* __restrict__ Q, int ldq, const u16* __restrict__ Kp, int ldk, const u16* __restrict__ VT,
                   u16* __restrict__ Yp, int q0, int kb, int nblk, int r, const float* rpb_s) {
  constexpr int NKS = DQK / 32;
  const int lane = otid() & 63, w = otid() >> 6, l15 = lane & 15, quad = lane >> 4;
  const int qrow0 = q0 + w * 16 * NQT;
  bf16x8 qf[NQT][NKS];
#pragma unroll
  for (int qt = 0; qt < NQT; qt++)
#pragma unroll
    for (int ks = 0; ks < NKS; ks++) qf[qt][ks] = ldfrag(Q + (size_t)(qrow0 + qt * 16 + l15) * ldq + ks * 32 + quad * 8);
  f32x4 o[NQT][4]; float m[NQT], lsum[NQT];
#pragma unroll
  for (int qt = 0; qt < NQT; qt++) {
    m[qt] = -1e30f; lsum[qt] = 0.f;
#pragma unroll
    for (int dt = 0; dt < 4; dt++) o[qt][dt] = f32x4{0.f, 0.f, 0.f, 0.f};
  }
  const int rs = NA ? min(max(r - 4, 0), 56) : 0;
  const int kscol = NA ? (w == 0 ? 0 : (w == 1 ? 8 : (w == 2 ? 24 : 32))) : 0;
  const int qc = w * 16 + l15;
  const int cs = min(max(qc - 8, 0), 48);
  auto kbase_of = [&](int blk) -> int {
    if (NA) return (blk < 8) ? ((rs + blk) * 64 + kscol) : (LAT + (blk - 8) * 32);
    return kb + blk * 32;
  };
  auto compute = [&](const KVStage<NKS>& st, int blk) {
#pragma unroll
    for (int qt = 0; qt < NQT; qt++) {
      f32x4 s0 = f32x4{0.f, 0.f, 0.f, 0.f}, s1 = f32x4{0.f, 0.f, 0.f, 0.f};
#pragma unroll
      for (int ks = 0; ks < NKS; ks++) { s0 = MFMA(st.kf[0][ks], qf[qt][ks], s0); s1 = MFMA(st.kf[1][ks], qf[qt][ks], s1); }
      if (NA && blk < 8) {
        const int dr = rs + blk - r + 7;
#pragma unroll
        for (int j = 0; j < 4; j++) {
          const int kc0 = kscol + quad * 4 + j, kc1 = kc0 + 16;
          const bool v0 = (kc0 >= cs) && (kc0 < cs + 16), v1 = (kc1 >= cs) && (kc1 < cs + 16);
          s0[j] = v0 ? s0[j] + rpb_s[dr * 31 + (kc0 - qc + 15)] : -1e30f;
          s1[j] = v1 ? s1[j] + rpb_s[dr * 31 + (kc1 - qc + 15)] : -1e30f;
        }
      }
      float mx = fmaxf(fmaxf(fmaxf(s0[0], s0[1]), fmaxf(s0[2], s0[3])), fmaxf(fmaxf(s1[0], s1[1]), fmaxf(s1[2], s1[3])));
      mx = quad_max(mx);
      const float mnew = fmaxf(m[qt], mx);
      if (__builtin_amdgcn_ballot_w64(mnew != m[qt]) != 0ull) {
        const float alpha = __builtin_amdgcn_exp2f(m[qt] - mnew);
        lsum[qt] *= alpha;
#pragma unroll
        for (int dt = 0; dt < 4; dt++) { o[qt][dt][0] *= alpha; o[qt][dt][1] *= alpha; o[qt][dt][2] *= alpha; o[qt][dt][3] *= alpha; }
        m[qt] = mnew;
      }
      float pv[8]; float ps = 0;
#pragma unroll
      for (int j = 0; j < 4; j++) { pv[j] = __builtin_amdgcn_exp2f(s0[j] - mnew); pv[4 + j] = __builtin_amdgcn_exp2f(s1[j] - mnew); }
#pragma unroll
      for (int j = 0; j < 8; j++) ps += pv[j];
      lsum[qt] += ps;
      const bf16x8 pf = as_frag(pack8u(pv));
#pragma unroll
      for (int dt = 0; dt < 4; dt++) o[qt][dt] = MFMA(st.vf[dt], pf, o[qt][dt]);
    }
  };
  KVStage<NKS> sa, sb;
  kv_load(sa, Kp, ldk, VT, kbase_of(0), l15, quad);
  kv_load(sb, Kp, ldk, VT, kbase_of(1), l15, quad);
  for (int blk = 0; blk < nblk; blk += 2) {
    compute(sa, blk);
    if (blk + 2 < nblk) kv_load(sa, Kp, ldk, VT, kbase_of(blk + 2), l15, quad);
    compute(sb, blk + 1);
    if (blk + 3 < nblk) kv_load(sb, Kp, ldk, VT, kbase_of(blk + 3), l15, quad);
  }
#pragma unroll
  for (int qt = 0; qt < NQT; qt++) {
    const float inv = 1.f / quad_sum(lsum[qt]);
    u16* yr = Yp + (size_t)(qrow0 + qt * 16 + l15) * D;
#pragma unroll
    for (int dt = 0; dt < 4; dt++)
      *(uint2*)(yr + dt * 16 + quad * 4) = make_uint2(pack2(o[qt][dt][0] * inv, o[qt][dt][1] * inv), pack2(o[qt][dt][2] * inv, o[qt][dt][3] * inv));
  }
}

constexpr int KS_LD = 104, VS_LD = 72;
constexpr int KS_TILE = 64 * KS_LD, VS_TILE = 64 * VS_LD;
template <int NQT>
DI void attn_mla_lds(const u16* __restrict__ Q, const u16* __restrict__ Kp, const u16* __restrict__ VT, u16* __restrict__ Yp,
                     int q0, int kb, int ntile, u16* sm) {
  constexpr int NKS = 3, ldq = 512, ldk = 512;
  const int tid = otid(), lane = tid & 63, w = tid >> 6, l15 = lane & 15, quad = lane >> 4;
  const int qrow0 = q0 + w * 16 * NQT;
  u16* Ks = sm;
  u16* Vs = sm + 2 * KS_TILE;
  bf16x8 qf[NQT][NKS];
#pragma unroll
  for (int qt = 0; qt < NQT; qt++)
#pragma unroll
    for (int ks = 0; ks < NKS; ks++) qf[qt][ks] = ldfrag(Q + (size_t)(qrow0 + qt * 16 + l15) * ldq + ks * 32 + quad * 8);
  f32x4 o[NQT][4]; float m[NQT], lsum[NQT];
#pragma unroll
  for (int qt = 0; qt < NQT; qt++) {
    m[qt] = -1e30f; lsum[qt] = 0.f;
#pragma unroll
    for (int dt = 0; dt < 4; dt++) o[qt][dt] = f32x4{0.f, 0.f, 0.f, 0.f};
  }
  const int kc0 = tid, kc1 = tid + 256, kc2 = tid + 512;
  const int kg0 = (kc0 / 12) * ldk + (kc0 % 12) * 8, kg1 = (kc1 / 12) * ldk + (kc1 % 12) * 8, kg2 = (kc2 / 12) * ldk + (kc2 % 12) * 8;
  const int kl0 = (kc0 / 12) * KS_LD + (kc0 % 12) * 8, kl1 = (kc1 / 12) * KS_LD + (kc1 % 12) * 8, kl2 = (kc2 / 12) * KS_LD + (kc2 % 12) * 8;
  const int vc0 = tid, vc1 = tid + 256;
  const size_t vg0 = (size_t)(vc0 >> 3) * TB + (vc0 & 7) * 8, vg1 = (size_t)(vc1 >> 3) * TB + (vc1 & 7) * 8;
  const int vl0 = (vc0 >> 3) * VS_LD + (vc0 & 7) * 8, vl1 = (vc1 >> 3) * VS_LD + (vc1 & 7) * 8;
  uint4 rk0, rk1, rk2, rv0, rv1;
  {
    const u16* kp = Kp + (size_t)kb * ldk; const u16* vp = VT + kb;
    rk0 = *(const uint4*)(kp + kg0); rk1 = *(const uint4*)(kp + kg1); rk2 = *(const uint4*)(kp + kg2);
    rv0 = *(const uint4*)(vp + vg0); rv1 = *(const uint4*)(vp + vg1);
  }
  __syncthreads();
  *(uint4*)(Ks + kl0) = rk0; *(uint4*)(Ks + kl1) = rk1; *(uint4*)(Ks + kl2) = rk2;
  *(uint4*)(Vs + vl0) = rv0; *(uint4*)(Vs + vl1) = rv1;
  __syncthreads();
  for (int t = 0; t < ntile; t++) {
    const int cur = t & 1;
    if (t + 1 < ntile) {
      const u16* kp = Kp + (size_t)(kb + (t + 1) * 64) * ldk; const u16* vp = VT + kb + (t + 1) * 64;
      rk0 = *(const uint4*)(kp + kg0); rk1 = *(const uint4*)(kp + kg1); rk2 = *(const uint4*)(kp + kg2);
      rv0 = *(const uint4*)(vp + vg0); rv1 = *(const uint4*)(vp + vg1);
    }
    const u16* ks_ = Ks + cur * KS_TILE; const u16* vs_ = Vs + cur * VS_TILE;
#pragma unroll
    for (int sub = 0; sub < 2; sub++) {
      bf16x8 kf[2][NKS], vf[4];
#pragma unroll
      for (int kt = 0; kt < 2; kt++)
#pragma unroll
        for (int ks = 0; ks < NKS; ks++) kf[kt][ks] = ldfrag(ks_ + (sub * 32 + kt * 16 + l15) * KS_LD + ks * 32 + quad * 8);
#pragma unroll
      for (int dt = 0; dt < 4; dt++) {
        const u16* vp = vs_ + (dt * 16 + l15) * VS_LD + sub * 32 + quad * 4;
        const uint2 lo = *(const uint2*)vp, hi = *(const uint2*)(vp + 16);
        vf[dt] = as_frag(make_uint4(lo.x, lo.y, hi.x, hi.y));
      }
#pragma unroll
      for (int qt = 0; qt < NQT; qt++) {
        f32x4 s0 = f32x4{0.f, 0.f, 0.f, 0.f}, s1 = f32x4{0.f, 0.f, 0.f, 0.f};
#pragma unroll
        for (int ks = 0; ks < NKS; ks++) { s0 = MFMA(kf[0][ks], qf[qt][ks], s0); s1 = MFMA(kf[1][ks], qf[qt][ks], s1); }
        float mx = fmaxf(fmaxf(fmaxf(s0[0], s0[1]), fmaxf(s0[2], s0[3])), fmaxf(fmaxf(s1[0], s1[1]), fmaxf(s1[2], s1[3])));
        mx = quad_max(mx);
        const float mnew = fmaxf(m[qt], mx);
        if (__builtin_amdgcn_ballot_w64(mnew != m[qt]) != 0ull) {
          const float alpha = __builtin_amdgcn_exp2f(m[qt] - mnew);
          lsum[qt] *= alpha;
#pragma unroll
          for (int dt = 0; dt < 4; dt++) { o[qt][dt][0] *= alpha; o[qt][dt][1] *= alpha; o[qt][dt][2] *= alpha; o[qt][dt][3] *= alpha; }
          m[qt] = mnew;
        }
        float pv[8]; float ps = 0;
#pragma unroll
        for (int j = 0; j < 4; j++) { pv[j] = __builtin_amdgcn_exp2f(s0[j] - mnew); pv[4 + j] = __builtin_amdgcn_exp2f(s1[j] - mnew); }
#pragma unroll
        for (int j = 0; j < 8; j++) ps += pv[j];
        lsum[qt] += ps;
        const bf16x8 pf = as_frag(pack8u(pv));
#pragma unroll
        for (int dt = 0; dt < 4; dt++) o[qt][dt] = MFMA(vf[dt], pf, o[qt][dt]);
      }
    }
    if (t + 1 < ntile) {
      u16* kd = Ks + (cur ^ 1) * KS_TILE; u16* vd = Vs + (cur ^ 1) * VS_TILE;
      *(uint4*)(kd + kl0) = rk0; *(uint4*)(kd + kl1) = rk1; *(uint4*)(kd + kl2) = rk2;
      *(uint4*)(vd + vl0) = rv0; *(uint4*)(vd + vl1) = rv1;
    }
    __syncthreads();
  }
#pragma unroll
  for (int qt = 0; qt < NQT; qt++) {
    const float inv = 1.f / quad_sum(lsum[qt]);
    u16* yr = Yp + (size_t)(qrow0 + qt * 16 + l15) * D;
#pragma unroll
    for (int dt = 0; dt < 4; dt++)
      *(uint2*)(yr + dt * 16 + quad * 4) = make_uint2(pack2(o[qt][dt][0] * inv, o[qt][dt][1] * inv), pack2(o[qt][dt][2] * inv, o[qt][dt][3] * inv));
  }
}

DI void phase_c(const Params& p, int l, unsigned char* smem) {
  constexpr int NPREP = RH / 16, NHG1 = 16 * 68;
  const int npool = 128 + (l == 0 ? 8 : 0);
  const int G = gridDim.x, bid = blockIdx.x;
  for (int v = bid; v < NHG1; v += G) hg1_task(p, l, v, smem);
  for (int v = (bid + G - (NHG1 % G)) % G; v < NPREP; v += G) prep_task(p, l, v);
  for (int v = (bid + 2 * G - (NHG1 % G) - (NPREP % G)) % G; v < npool; v += G) pool_task(p, l, v, smem);
}

DI void phase_d_task(const Params& p, int l, int t, unsigned char* smem) {
  const u16* Qm = (const u16*)(p.ws + WS_QM); const u16* Km = (const u16*)(p.ws + WS_KM); const u16* VTm = (const u16*)(p.ws + WS_VTM);
  const u16* Qn = (const u16*)(p.ws + WS_QN); const u16* Kn = (const u16*)(p.ws + WS_KN); const u16* VTn = (const u16*)(p.ws + WS_VTN);
  u16* Y = (u16*)(p.ws + WS_Y);
  float* rpb_s = (float*)smem;
  if (t < 256) {
    const int bb = t >> 7, h = (t >> 5) & 3, qb = t & 31;
    attn_mla_lds<2>(Qm + (size_t)bb * TB * 512 + h * 128, Km + (size_t)bb * TB * 512 + h * 128,
                    VTm + (size_t)(bb * 4 + h) * 64 * TB, Y + (size_t)bb * TB * D + 256 + h * 64, qb * 128, 0, TB / 64, (u16*)(smem + 2048));
    return;
  }
  t -= 256;
  if (t < 256) { hg2_task(p, t); return; }
  t -= 256;
  if (t < 512) {
    const int bb = t >> 8, h = (t >> 6) & 3, r = t & 63;
    __syncthreads();
    for (int i = otid(); i < 15 * 31; i += 256) rpb_s[i] = p.in[IRPB][(size_t)(l * 4 + h) * 465 + i] * 1.4426950408889634f;
    __syncthreads();
    attn_block<64, 1, true>(Qn + (size_t)bb * TB * 256 + h * 64, 256, Kn + (size_t)bb * TB * 256 + h * 64, 256,
                            VTn + (size_t)(bb * 4 + h) * 64 * TB, Y + (size_t)bb * TB * D + 512 + h * 64, r * 64, 0, 16, r, rpb_s);
    return;
  }
  t -= 512;
  if (t < 16) {
    const int bb = t >> 3, h = (t >> 1) & 3, qb = t & 1;
    attn_mla_lds<2>(Qm + (size_t)bb * TB * 512 + h * 128, Km + (size_t)bb * TB * 512 + h * 128,
                    VTm + (size_t)(bb * 4 + h) * 64 * TB, Y + (size_t)bb * TB * D + 256 + h * 64, LAT + qb * 128, LAT, CL / 64, (u16*)(smem + 2048));
    return;
  }
  t -= 16;
  {
    const int bb = t >> 3, h = (t >> 1) & 3, qb = t & 1;
    attn_block<64, 2, false>(Qn + (size_t)bb * TB * 256 + h * 64, 256, Kn + (size_t)bb * TB * 256 + h * 64, 256,
                             VTn + (size_t)(bb * 4 + h) * 64 * TB, Y + (size_t)bb * TB * D + 512 + h * 64, LAT + qb * 128, LAT, CL / 32, 0, nullptr);
  }
}

DI void phase_d(const Params& p, int l, unsigned char* smem) {
  const int G = gridDim.x, b = blockIdx.x;
  if (G == 512) {
    if (b < 256) { phase_d_task(p, l, b, smem); }
    else {
      const int r = b - 256;
      phase_d_task(p, l, 256 + r, smem);
      phase_d_task(p, l, 512 + r, smem);
      phase_d_task(p, l, 768 + r, smem);
      if (l == 0 && r < 32) phase_d_task(p, l, 1024 + r, smem);
    }
  } else {
    const int total = 256 + 256 + 512 + (l == 0 ? 32 : 0);
    for (int v = b; v < total; v += G) phase_d_task(p, l, v, smem);
  }
}

DI void phase_e(const Params& p, int l, unsigned char* smem) {
  const int total = 512 + (l == 0 ? 32 : 0);
  for (int v = blockIdx.x; v < total; v += gridDim.x) hg3_task(p, l, v, smem);
}


#define XB_TMO      128
#define XB_XCNT(j)  (256  + 64 * (j))
#define XB_XSUB(j)  (1280 + 64 * (j))
#define XB_XGEN(j)  (2304 + 64 * (j))
#define XB_TOP      3328
#define XB_TOPGEN   3392
#define XCD_BAR_WORDS 3456
#define XB_SPIN_CAP (1u << 20)
#define LAS __attribute__((address_space(3)))
DI unsigned xb_ld(unsigned* p) { return __hip_atomic_load(p, __ATOMIC_RELAXED, __HIP_MEMORY_SCOPE_AGENT); }
DI unsigned xb_add(unsigned* p, unsigned v) { return __hip_atomic_fetch_add(p, v, __ATOMIC_RELAXED, __HIP_MEMORY_SCOPE_AGENT); }
DI unsigned xb_xcc_id() { return (unsigned)__builtin_amdgcn_s_getreg((3 << 11) | 20) & 0xFu; }
#define XB_SPIN(cond, bar) do { unsigned _sp = 0; while (cond) { __builtin_amdgcn_s_sleep(1); \
    if ((++_sp & 255u) == 0u) { if (xb_ld(&(bar)[XB_TMO])) break; if (_sp > XB_SPIN_CAP) { atomicAdd(&(bar)[XB_TMO], 1u); break; } } } } while (0)
struct XcdBarrier { unsigned* bar; unsigned x; volatile LAS unsigned* st; };
DI XcdBarrier xcd_barrier_post(unsigned* bar, volatile LAS unsigned* st) {
  XcdBarrier b; b.bar = bar; b.x = xb_xcc_id(); b.st = st;
  if (threadIdx.x == 0) (void)xb_add(&bar[XB_XCNT(b.x)], 1u);
  return b;
}
DI void xcd_barrier_complete(unsigned* bar, unsigned x, unsigned& nloc, unsigned& nx) {
  const unsigned G = gridDim.x * gridDim.y * gridDim.z;
  unsigned sum, cnt, mine, sp = 0u;
  for (;;) {
    sum = 0u; cnt = 0u; mine = 0u;
#pragma unroll
    for (unsigned j = 0; j < 16; ++j) { const unsigned c = xb_ld(&bar[XB_XCNT(j)]); sum += c; cnt += (c > 0u) ? 1u : 0u; mine = (j == x) ? c : mine; }
    if (sum == G) break;
    __builtin_amdgcn_s_sleep(1);
    if ((++sp & 255u) == 0u) { if (xb_ld(&bar[XB_TMO])) break; if (sp > XB_SPIN_CAP) { atomicAdd(&bar[XB_TMO], 1u); break; } }
  }
  nloc = mine > 0u ? mine : 1u; nx = cnt > 0u ? cnt : 1u;
}
DI void xcd_barrier(const XcdBarrier& b) {
  asm volatile("s_waitcnt vmcnt(0)" ::: "memory");
  __syncthreads();
  if (threadIdx.x == 0) {
    unsigned* bar = b.bar;
    __builtin_amdgcn_s_waitcnt(0);
    unsigned nloc = b.st[0], nx = b.st[1];
    if (nloc == 0u) { xcd_barrier_complete(bar, b.x, nloc, nx); b.st[0] = nloc; b.st[1] = nx; }
    const unsigned old = xb_add(&bar[XB_XSUB(b.x)], 1u);
    const unsigned gen = old / nloc;
    if (old + 1u == (gen + 1u) * nloc) {
      __builtin_amdgcn_fence(__ATOMIC_RELEASE, "agent");
      asm volatile("s_waitcnt vmcnt(0)" ::: "memory");
      const unsigned og = xb_add(&bar[XB_TOP], 1u);
      const unsigned tg = og / nx;
      if (og + 1u == (tg + 1u) * nx) xb_add(&bar[XB_TOPGEN], 1u);
      else XB_SPIN(xb_ld(&bar[XB_TOPGEN]) == tg, bar);
      __builtin_amdgcn_fence(__ATOMIC_ACQUIRE, "agent");
      xb_add(&bar[XB_XGEN(b.x)], 1u);
      asm volatile("s_waitcnt vmcnt(0)" ::: "memory");
    } else {
      XB_SPIN(xb_ld(&bar[XB_XGEN(b.x)]) == gen, bar);
      __builtin_amdgcn_fence(__ATOMIC_ACQUIRE, "agent");
      asm volatile("s_waitcnt vmcnt(0)" ::: "memory");
    }
  }
  __syncthreads();
}

constexpr int LDS_BYTES = 4 * 128 * LDT * 2 + 16;
__global__ void __launch_bounds__(256, 2) mega(Params p, int ph_lo, int ph_hi) {
  cg::grid_group grid = cg::this_grid();
  extern __shared__ __attribute__((aligned(16))) unsigned char smem[];
  u16* sm16 = (u16*)smem;
  volatile LAS unsigned* xst = (volatile LAS unsigned*)(smem + LDS_BYTES - 16);
  if (threadIdx.x == 0) { xst[0] = 0u; xst[1] = 0u; }
  __syncthreads();
  const XcdBarrier xb = xcd_barrier_post((unsigned*)(p.ws + WS_BAR), xst);
  for (int ph = ph_lo; ph < ph_hi; ph++) {
    const int l = ph / 21, q = ph - l * 21;
    const int half = (q == 0) ? 0 : (q - 1) / 10;
    const int k = (q == 0) ? -1 : (q - 1) % 10;
    if (k == 0 && (l | half)) continue;
    switch (k) {
      case -1: phase_conv(p, l, smem); break;
      case 0: phase_norm(p, l, half, 0); break;
      case 1: phase_gemm_in(p, l, sm16); break;
      case 2: phase_c(p, l, smem); break;
      case 3: phase_d(p, l, smem); break;
      case 4: phase_e(p, l, smem); break;
      case 5: phase_merge(p, l, sm16); break;
      case 6: phase_resid(p, l, half, 0, sm16); break;
      case 7: phase_norm(p, l, half, 1); break;
      case 8: phase_ff1(p, l, sm16); break;
      default:
        phase_resid(p, l, half, 1, sm16);
        if (half == 0) phase_norm(p, l, 1, 0, (l == 0 && gridDim.x == 512) ? 32 : 0, (l == 0 && gridDim.x == 512) ? 480 : 0);
        else if (l == 0) phase_norm(p, 1, 0, 0, (gridDim.x == 512) ? 32 : 0, (gridDim.x == 512) ? 480 : 0);
        break;
    }
    if (ph + 1 < ph_hi) {
      if (ph_lo < 0) { asm volatile("s_waitcnt vmcnt(0)" ::: "memory"); grid.sync(); }
      xcd_barrier(xb);
    }
  }
}

extern "C" void kernel_launch(void* const* d_in, const int* in_sizes, int n_in, void* d_out, int out_size, void* d_ws,
                              size_t ws_size, hipStream_t stream) {
  static int grid_blocks = 0;
  if (!grid_blocks) {
    int dev = 0, cus = 0, per_cu = 0;
    hipGetDevice(&dev);
    hipDeviceGetAttribute(&cus, hipDeviceAttributeMultiprocessorCount, dev);
    hipFuncSetAttribute((const void*)mega, hipFuncAttributeMaxDynamicSharedMemorySize, LDS_BYTES);
    hipOccupancyMaxActiveBlocksPerMultiprocessor(&per_cu, mega, 256, LDS_BYTES);
    if (per_cu < 1) per_cu = 1;
    if (per_cu > 2) per_cu = 2;
    grid_blocks = cus * per_cu;
    if (ws_size < WS_END) fprintf(stderr, "kernel_launch: workspace too small: %zu < %zu\n", ws_size, (size_t)WS_END);
    if (n_in != NIN) fprintf(stderr, "kernel_launch: expected %d inputs, got %d\n", (int)NIN, n_in);
  }
  Params p{};
  for (int i = 0; i < NIN; i++) p.in[i] = (const float*)d_in[i];
  p.out = (float*)d_out;
  p.ws = (unsigned char*)d_ws;
  int ph_lo = 0, ph_hi = 42;
  hipMemsetAsync((unsigned char*)d_ws + WS_BAR, 0, XCD_BAR_WORDS * 4, stream);
  void* args[] = {&p, &ph_lo, &ph_hi};
  hipError_t e = hipLaunchCooperativeKernel((void*)mega, dim3(grid_blocks), dim3(256), args, LDS_BYTES, stream);
  if (e != hipSuccess) fprintf(stderr, "cooperative launch failed: %s (grid %d)\n", hipGetErrorString(e), grid_blocks);
}
```
